# Optimizing an MI355X kernel written in HIP

```python
import math
import jax, jax.numpy as jnp
from jax import lax
import numpy as np

D_MODEL = 2048
BATCH = 16
SEQ = 256
DEPTH = 4
DEC_BATCH = 8
DEC_SEQ = 1024
PAST_LEN = 256

GRID_W = 64
HEAD_DIM = 128
NA_HEADS = 4
GQA_Q_HEADS = 8
GQA_KV_HEADS = 2
GQA_GROUP = GQA_Q_HEADS // GQA_KV_HEADS
DIFF_HEADS = 4
DIFF_QK_DIM = HEAD_DIM // 2
NA_KH = 8
NA_KW = 16
NA_QC = NA_KW
NA_CB = 2 * NA_KW
Q_BLOCK = 128
D_FF = 4 * D_MODEL
ROPE_THETA = 10000.0
EPS = 1e-6
N_MOD = 6
NEG_BIG = -1e30

NA_W = NA_HEADS * HEAD_DIM
GQA_QW = GQA_Q_HEADS * HEAD_DIM
GQA_KVW = GQA_KV_HEADS * HEAD_DIM
DIFF_W = DIFF_HEADS * HEAD_DIM
D_IN = 3 * NA_W + GQA_QW + 2 * GQA_KVW + 3 * DIFF_W
D_MIX = NA_W + GQA_QW + DIFF_W
IN_SPLITS = (NA_W, 2 * NA_W, 3 * NA_W,
             3 * NA_W + GQA_QW,
             3 * NA_W + GQA_QW + GQA_KVW,
             3 * NA_W + GQA_QW + 2 * GQA_KVW,
             3 * NA_W + GQA_QW + 2 * GQA_KVW + DIFF_W,
             3 * NA_W + GQA_QW + 2 * GQA_KVW + 2 * DIFF_W)

kernel_name = "hybrid_diffusion_prefix_trunk_step"


def rms_norm(x, g):
    xf = x.astype(jnp.float32)
    y = xf * lax.rsqrt(jnp.mean(xf * xf, axis=-1, keepdims=True) + EPS)
    return (y * g.astype(jnp.float32)).astype(x.dtype)


def rope_1d(x, pos):
    T = x.shape[1]
    half = x.shape[-1] // 2
    inv = ROPE_THETA ** (-jnp.arange(half, dtype=jnp.float32) / half)
    ang = pos.astype(jnp.float32)[:, None] * inv[None, :]
    bshape = (T,) + (1,) * (x.ndim - 3) + (half,)
    cos = jnp.cos(ang).reshape(bshape)
    sin = jnp.sin(ang).reshape(bshape)
    x1 = x[..., :half].astype(jnp.float32)
    x2 = x[..., half:].astype(jnp.float32)
    return jnp.concatenate([x1 * cos - x2 * sin, x2 * cos + x1 * sin], axis=-1).astype(x.dtype)


def axial_rope(x):
    T = x.shape[1]
    t = jnp.arange(T)
    d = x.shape[-1]
    return jnp.concatenate([rope_1d(x[..., : d // 2], t // GRID_W),
                            rope_1d(x[..., d // 2:], t % GRID_W)], axis=-1)


def sweep_query_blocks(fn, q):
    B, T = q.shape[:2]
    nb = T // Q_BLOCK
    qb = q.reshape((B, nb, Q_BLOCK) + q.shape[2:]).swapaxes(0, 1)
    out = lax.map(fn, qb)
    return out.swapaxes(0, 1).reshape((B, T) + out.shape[3:])


def dense_attention(q, k, v):
    scale = q.shape[-1] ** -0.5
    def block(qb):
        s = jnp.einsum('bqkgd,bskd->bkgqs', qb, k).astype(jnp.float32) * scale
        p = jax.nn.softmax(s, axis=-1).astype(v.dtype)
        return jnp.einsum('bkgqs,bskd->bqkgd', p, v)
    return sweep_query_blocks(block, q)


def diff_attention(q, k, v, lam):
    scale = q.shape[-1] ** -0.5
    def block(qb):
        s = jnp.einsum('bqhmd,bshmd->bhmqs', qb, k).astype(jnp.float32) * scale
        p = jax.nn.softmax(s, axis=-1)
        a = (p[:, :, 0] - lam * p[:, :, 1]).astype(v.dtype)
        return jnp.einsum('bhqs,bshd->bqhd', a, v)
    return sweep_query_blocks(block, q)


def diff_lambda(lam_vec, lambda_init):
    lf = lam_vec.astype(jnp.float32)
    return jnp.exp(jnp.sum(lf[0] * lf[1])) - jnp.exp(jnp.sum(lf[2] * lf[3])) + lambda_init


def neighbourhood_attention(q, k, v, k_ctx, v_ctx, rpb):
    B, T, H, d = q.shape
    rows = T // GRID_W
    kh = min(NA_KH, rows)
    ncb = GRID_W // NA_QC
    scale = d ** -0.5
    r = jnp.arange(rows)
    r0 = jnp.clip(r - kh // 2, 0, rows - kh)
    row_idx = r0[:, None] + jnp.arange(kh)[None, :]
    j = jnp.arange(ncb)
    c0 = jnp.clip(j * NA_QC - NA_KW // 2, 0, GRID_W - NA_CB)
    col_idx = c0[:, None] + jnp.arange(NA_CB)[None, :]
    qc = j[:, None] * NA_QC + jnp.arange(NA_QC)[None, :]
    ws = jnp.clip(qc - NA_KW // 2, 0, GRID_W - NA_KW)
    ri = row_idx[:, None, :, None]
    ci = col_idx[None, :, None, :]
    n_loc = kh * NA_CB
    kg = k.reshape(B, rows, GRID_W, H, d)[:, ri, ci].reshape(B, rows, ncb, n_loc, H, d)
    vg = v.reshape(B, rows, GRID_W, H, d)[:, ri, ci].reshape(B, rows, ncb, n_loc, H, d)
    cand = col_idx[:, None, :]
    valid = (cand >= ws[:, :, None]) & (cand < ws[:, :, None] + NA_KW)
    drow = (row_idx - r[:, None] + NA_KH - 1).reshape(rows, 1, 1, kh, 1)
    dcol = jnp.clip(cand - qc[:, :, None] + NA_KW - 1, 0, 2 * NA_KW - 2).reshape(1, ncb, NA_QC, 1, NA_CB)
    bias = rpb.astype(jnp.float32)[:, drow, dcol]
    bias = jnp.where(valid[None, None, :, :, None, :], bias, NEG_BIG)
    bias = bias.reshape(H, rows, ncb, NA_QC, n_loc).transpose(1, 2, 0, 3, 4)
    qg = q.reshape(B, rows, ncb, NA_QC, H, d)
    s_loc = jnp.einsum('brjqhd,brjnhd->brjhqn', qg, kg).astype(jnp.float32) * scale + bias
    s_ctx = jnp.einsum('brjqhd,blhd->brjhql', qg, k_ctx).astype(jnp.float32) * scale
    p = jax.nn.softmax(jnp.concatenate([s_loc, s_ctx], axis=-1), axis=-1).astype(v.dtype)
    o = (jnp.einsum('brjhqn,brjnhd->brjqhd', p[..., :n_loc], vg)
         + jnp.einsum('brjhql,blhd->brjqhd', p[..., n_loc:], v_ctx))
    return o.reshape(B, T, H, d)


def modulation(cvec, w_ada_l, b_ada_l):
    m = jax.nn.silu(cvec) @ w_ada_l + b_ada_l
    return jnp.split(m[:, None, :], N_MOD, axis=-1)


def project(h, w_in_l):
    B, T, _ = h.shape
    parts = jnp.split(h @ w_in_l, IN_SPLITS, axis=-1)
    return [p.reshape(B, T, -1, HEAD_DIM) for p in parts]


def split_maps(a):
    return a.reshape(a.shape[:-1] + (2, DIFF_QK_DIM))


def merge_heads(o_na, o_gqa, o_diff, diff_g_l, lambda_init, w_out_l):
    B, T = o_na.shape[:2]
    o_diff = rms_norm(o_diff, diff_g_l) * (1.0 - lambda_init)
    o = jnp.concatenate([o_na.reshape(B, T, NA_W), o_gqa.reshape(B, T, GQA_QW),
                         o_diff.reshape(B, T, DIFF_W)], axis=-1)
    return o @ w_out_l


def mix_context(h, w_in_l, w_out_l, q_g, k_g, lam_vec, diff_g_l, lambda_init):
    B, T, _ = h.shape
    na_q, na_k, na_v, g_q, g_k, g_v, d_q, d_k, d_v = project(h, w_in_l)
    g_q = rms_norm(g_q, q_g)
    g_k = rms_norm(g_k, k_g)
    o_na = dense_attention(na_q[:, :, :, None], na_k, na_v)
    o_gqa = dense_attention(g_q.reshape(B, T, GQA_KV_HEADS, GQA_GROUP, HEAD_DIM), g_k, g_v)
    lam = diff_lambda(lam_vec, lambda_init)
    o_diff = diff_attention(split_maps(d_q), split_maps(d_k), d_v, lam)
    o = merge_heads(o_na, o_gqa, o_diff, diff_g_l, lambda_init, w_out_l)
    return o, (na_k, na_v, g_k, g_v, d_k, d_v)


def mix_latent(h, ctx, w_in_l, w_out_l, rpb_l, q_g, k_g, lam_vec, diff_g_l, lambda_init):
    B, T, _ = h.shape
    na_kc, na_vc, g_kc, g_vc, d_kc, d_vc = ctx
    na_q, na_k, na_v, g_q, g_k, g_v, d_q, d_k, d_v = project(h, w_in_l)
    o_na = neighbourhood_attention(na_q, na_k, na_v, na_kc, na_vc, rpb_l)
    g_q = axial_rope(rms_norm(g_q, q_g))
    g_k = axial_rope(rms_norm(g_k, k_g))
    o_gqa = dense_attention(g_q.reshape(B, T, GQA_KV_HEADS, GQA_GROUP, HEAD_DIM),
                            jnp.concatenate([g_k, g_kc], axis=1),
                            jnp.concatenate([g_v, g_vc], axis=1))
    lam = diff_lambda(lam_vec, lambda_init)
    o_diff = diff_attention(axial_rope(split_maps(d_q)),
                            jnp.concatenate([axial_rope(split_maps(d_k)), split_maps(d_kc)], axis=1),
                            jnp.concatenate([d_v, d_vc], axis=1), lam)
    return merge_heads(o_na, o_gqa, o_diff, diff_g_l, lambda_init, w_out_l)


def squared_relu_mlp(h, w_up_l, w_down_l):
    return jnp.square(jax.nn.relu(h @ w_up_l)) @ w_down_l


def setup_inputs(seed: int = 0) -> dict:
    key = jax.random.key(seed)
    ks = jax.random.split(key, 22)
    f32 = jnp.float32
    def nrm(k, shape, s):
        return s * jax.random.normal(k, shape, f32)
    return {
        "x_prompt": nrm(ks[0], (BATCH, SEQ, D_MODEL), 1.0),
        "x_sample": nrm(ks[1], (DEC_BATCH, DEC_SEQ, D_MODEL), 1.0),
        "c": nrm(ks[2], (DEC_BATCH, D_MODEL), 1.0),
        "cache_na_k": nrm(ks[3], (DEC_BATCH, DEPTH, PAST_LEN, NA_HEADS, HEAD_DIM), 1.0),
        "cache_na_v": nrm(ks[4], (DEC_BATCH, DEPTH, PAST_LEN, NA_HEADS, HEAD_DIM), 1.0),
        "cache_gqa_k": nrm(ks[5], (DEC_BATCH, DEPTH, PAST_LEN, GQA_KV_HEADS, HEAD_DIM), 1.0),
        "cache_gqa_v": nrm(ks[6], (DEC_BATCH, DEPTH, PAST_LEN, GQA_KV_HEADS, HEAD_DIM), 1.0),
        "cache_diff_k": nrm(ks[7], (DEC_BATCH, DEPTH, PAST_LEN, DIFF_HEADS, HEAD_DIM), 1.0),
        "cache_diff_v": nrm(ks[8], (DEC_BATCH, DEPTH, PAST_LEN, DIFF_HEADS, HEAD_DIM), 1.0),
        "c_ctx": nrm(ks[9], (D_MODEL,), 1.0),
        "w_ada": nrm(ks[10], (DEPTH, D_MODEL, N_MOD * D_MODEL), D_MODEL ** -0.5),
        "b_ada": nrm(ks[11], (DEPTH, N_MOD * D_MODEL), 0.02),
        "norm_g": 1.0 + nrm(ks[12], (DEPTH, 4, D_MODEL), 0.02),
        "w_in": nrm(ks[13], (DEPTH, D_MODEL, D_IN), D_MODEL ** -0.5),
        "w_out": nrm(ks[14], (DEPTH, D_MIX, D_MODEL), D_MIX ** -0.5),
        "na_rpb": nrm(ks[15], (DEPTH, NA_HEADS, 2 * NA_KH - 1, 2 * NA_KW - 1), 0.1),
        "gqa_q_g": 1.0 + nrm(ks[16], (DEPTH, HEAD_DIM), 0.02),
        "gqa_k_g": 1.0 + nrm(ks[17], (DEPTH, HEAD_DIM), 0.02),
        "diff_lam": nrm(ks[18], (DEPTH, 4, DIFF_QK_DIM), 0.1),
        "diff_g": 1.0 + nrm(ks[19], (DEPTH, HEAD_DIM), 0.02),
        "w_up": nrm(ks[20], (DEPTH, D_MODEL, D_FF), D_MODEL ** -0.5),
        "w_down": nrm(ks[21], (DEPTH, D_FF, D_MODEL), D_FF ** -0.5),
    }


def reference(x_prompt, x_sample, c, cache_na_k, cache_na_v, cache_gqa_k, cache_gqa_v,
              cache_diff_k, cache_diff_v, c_ctx, w_ada, b_ada, norm_g, w_in, w_out,
              na_rpb, gqa_q_g, gqa_k_g, diff_lam, diff_g, w_up, w_down):
    xp = x_prompt
    xs = x_sample
    new_kv = [[] for _ in range(6)]
    for l in range(DEPTH):
        lambda_init = 0.8 - 0.6 * math.exp(-0.3 * l)
        g_pre_a, g_post_a, g_pre_m, g_post_m = norm_g[l, 0], norm_g[l, 1], norm_g[l, 2], norm_g[l, 3]
        sh_a, sc_a, gt_a, sh_m, sc_m, gt_m = modulation(c_ctx[None, :], w_ada[l], b_ada[l])
        h = rms_norm(xp, g_pre_a) * (1.0 + sc_a) + sh_a
        o, ctx_kv = mix_context(h, w_in[l], w_out[l], gqa_q_g[l], gqa_k_g[l],
                                diff_lam[l], diff_g[l], lambda_init)
        for i in range(6):
            new_kv[i].append(ctx_kv[i])
        xp = xp + gt_a * rms_norm(o, g_post_a)
        h = rms_norm(xp, g_pre_m) * (1.0 + sc_m) + sh_m
        xp = xp + gt_m * rms_norm(squared_relu_mlp(h, w_up[l], w_down[l]), g_post_m)
        sh_a, sc_a, gt_a, sh_m, sc_m, gt_m = modulation(c, w_ada[l], b_ada[l])
        h = rms_norm(xs, g_pre_a) * (1.0 + sc_a) + sh_a
        ctx = (cache_na_k[:, l], cache_na_v[:, l], cache_gqa_k[:, l], cache_gqa_v[:, l],
               cache_diff_k[:, l], cache_diff_v[:, l])
        o = mix_latent(h, ctx, w_in[l], w_out[l], na_rpb[l], gqa_q_g[l], gqa_k_g[l],
                       diff_lam[l], diff_g[l], lambda_init)
        xs = xs + gt_a * rms_norm(o, g_post_a)
        h = rms_norm(xs, g_pre_m) * (1.0 + sc_m) + sh_m
        xs = xs + gt_m * rms_norm(squared_relu_mlp(h, w_up[l], w_down[l]), g_post_m)
    new_na_k = jnp.stack(new_kv[0], axis=1)
    new_na_v = jnp.stack(new_kv[1], axis=1)
    new_gqa_k = jnp.stack(new_kv[2], axis=1)
    new_gqa_v = jnp.stack(new_kv[3], axis=1)
    new_diff_k = jnp.stack(new_kv[4], axis=1)
    new_diff_v = jnp.stack(new_kv[5], axis=1)
    return (xp, xs, new_na_k, new_na_v, new_gqa_k, new_gqa_v, new_diff_k, new_diff_v)
```

```cpp
#include <hip/hip_runtime.h>
#include <cstdio>
#include <cstdint>
#include <cmath>
namespace pg8 {
#define PG8_LAS __attribute__((address_space(3)))
typedef unsigned short bf16_t;
typedef short bf16x8 __attribute__((ext_vector_type(8)));
typedef float f32x4 __attribute__((ext_vector_type(4)));
typedef unsigned u32x4 __attribute__((ext_vector_type(4)));
constexpr int BM = 256, BK = 64, HALF = 128, HTB = HALF * BK * 2  , STAGE_BYTES = 8 * HTB, NXCD = 8, WGM = 8;

__host__ __device__ __forceinline__ int lds_byte(int r, int c) { const int st = (r >> 4) * 2 + (c >> 5), rr = r & 15, cc = c & 31, ob = rr * 64 + cc * 2; return st * 1024 + (ob ^ (((ob >> 9) & 1) << 5)); }
__host__ __device__ __forceinline__ void stage_rc(int b, int& R, int& C) { const int st = b / 1024, sb = b % 1024, swz = sb ^ (((sb >> 9) & 1) << 5); R = (st >> 1) * 16 + swz / 64; C = (st & 1) * 32 + (swz % 64) / 2; }
__host__ __device__ __forceinline__ int perm32(int rho) { const int n = rho >> 4, i = rho & 15; return 8 * (i >> 2) + 4 * n + (i & 3); }

struct Unit { int pm, pn; };
struct Gemm { const bf16_t* A; const bf16_t* Bt; int M, N, K; };

struct StaticOrder {
    int nM, nN, nwg, G, c;
    __host__ __device__ void init(int M, int N, int G_, int c_) { nM = M / BM; nN = N / BM; nwg = nM * nN; G = G_; c = c_; }
    __host__ __device__ bool next(int i, Unit& u) const {
        const long L = (long)i * G + c; if (L >= nwg) return false;
        int wgid = (int)L; { const int q = nwg / NXCD, r = nwg % NXCD, xcd = wgid % NXCD, off = wgid / NXCD; wgid = (xcd < r ? xcd * (q + 1) : r * (q + 1) + (xcd - r) * q) + off; }
        const int nig = WGM * nN, gid = wgid / nig, fm = gid * WGM, gsz = (nM - fm) < WGM ? (nM - fm) : WGM;
        u.pm = fm + ((wgid % nig) % gsz); u.pn = (wgid % nig) / gsz; return true;
    }
    __device__ __forceinline__ void a_ready(const Unit&) const {}
    __device__ __forceinline__ void done(const Unit&) const {}
};

__device__ __forceinline__ unsigned cvt_pk_bf16(float lo, float hi) { unsigned r; asm volatile("v_cvt_pk_bf16_f32 %0, %1, %2" : "=v"(r) : "v"(lo), "v"(hi)); return r; }
struct EpiF32 {
    static constexpr bool PERM = false, AFTER_DRAIN = false;
    float* C; int ldc;
    __device__ __forceinline__ void operator()(const f32x4 (&acc)[2][2][4][2], const Unit& u, int wr, int wc, int fr, int fq) const {
        const int row0 = u.pm * BM + wr * 64 + fr, col0 = u.pn * BM + wc * 32 + 4 * fq;
#pragma unroll
        for (int ai = 0; ai < 2; ++ai)
#pragma unroll
            for (int m = 0; m < 4; ++m) { float* rowp = C + (size_t)(row0 + ai * HALF + m * 16) * ldc + col0;
#pragma unroll
                for (int bj = 0; bj < 2; ++bj)
#pragma unroll
                    for (int n = 0; n < 2; ++n) *(f32x4*)(rowp + bj * HALF + n * 16) = acc[ai][bj][m][n]; }
    }
};
template <int ACT  > struct EpiBf16 {
    static constexpr bool PERM = true, AFTER_DRAIN = false;
    bf16_t* O; int ldc;
    __device__ __forceinline__ void operator()(const f32x4 (&acc)[2][2][4][2], const Unit& u, int wr, int wc, int fr, int fq) const {
        const int row0 = u.pm * BM + wr * 64 + fr; const int col0 = u.pn * BM + wc * 32 + 8 * fq;
#pragma unroll
        for (int ai = 0; ai < 2; ++ai)
#pragma unroll
            for (int m = 0; m < 4; ++m) { bf16_t* rowp = O + (size_t)(row0 + ai * HALF + m * 16) * ldc + col0;
#pragma unroll
                for (int bj = 0; bj < 2; ++bj) { f32x4 v0 = acc[ai][bj][m][0], v1 = acc[ai][bj][m][1];
                    if (ACT == 2) {
#pragma unroll
                        for (int j = 0; j < 4; ++j) { const float a = fmaxf(v0[j], 0.f), b = fmaxf(v1[j], 0.f); v0[j] = a * a; v1[j] = b * b; } }
                    u32x4 w; w.x = cvt_pk_bf16(v0[0], v0[1]); w.y = cvt_pk_bf16(v0[2], v0[3]); w.z = cvt_pk_bf16(v1[0], v1[1]); w.w = cvt_pk_bf16(v1[2], v1[3]);
                    *(u32x4*)(rowp + bj * HALF) = w; } }
    }
};

template <class Epi, class Sched, bool ALIGN_EPI = false, bool SP2 = false>
__device__ __forceinline__ void gemm_phase(PG8_LAS unsigned char* lds, const Gemm g, const Sched& S, const Epi& E) {
    int tid_ = threadIdx.x; asm volatile("" : "+v"(tid_)); const int tid = tid_, wid = __builtin_amdgcn_readfirstlane(tid >> 6), lane = tid & 63, wr = wid >> 2, wc = wid & 3, fr = lane & 15, fq = lane >> 4;
    const int K = g.K, nt = K / BK;
    unsigned voffA[2], voffB[2];
#pragma unroll
    for (int i = 0; i < 2; ++i) { int R, C; stage_rc(tid * 16 + i * 8192, R, C); const int Rb = Epi::PERM ? ((R & ~31) + perm32(R & 31)) : R;
        voffA[i] = (unsigned)(R * K + C) * 2u; voffB[i] = (unsigned)(Rb * K + C) * 2u; }
    const size_t kstep = (size_t)(BK * 2);
    const size_t hstep = (size_t)HALF * K * 2;
    const size_t tstep = 2 * hstep;
    const unsigned ldsw = (unsigned)wid * 1024u;
    const int aoff = lds_byte(wr * 64 + fr, fq * 8), boff = lds_byte(wc * 32 + fr, fq * 8);
#define PG8_SA(b, h) (((b) * 2 + (h)) * HTB)
#define PG8_SB(b, h) ((4 + (b) * 2 + (h)) * HTB)
#define PG8_STAGE(bufoff, gbase, voff) do { _Pragma("unroll") for (int _i = 0; _i < 2; ++_i) \
        __builtin_amdgcn_global_load_lds((const unsigned*)((const char*)(gbase) + (voff)[_i]), (PG8_LAS unsigned*)(lds + (bufoff) + ldsw + _i * 8192), 16, 0, 0); } while (0)
#define PG8_LDA(dst, b, h) do { _Pragma("unroll") for (int m = 0; m < 4; ++m) _Pragma("unroll") for (int k = 0; k < 2; ++k) dst[m][k] = *(const PG8_LAS bf16x8*)(lds + PG8_SA(b, h) + aoff + m * 2048 + k * 1024); } while (0)
#define PG8_LDB(dst, b, h) do { _Pragma("unroll") for (int n = 0; n < 2; ++n) _Pragma("unroll") for (int k = 0; k < 2; ++k) dst[n][k] = *(const PG8_LAS bf16x8*)(lds + PG8_SB(b, h) + boff + n * 2048 + k * 1024); } while (0)
#define PG8_MMA(ai, bj, At, Bt) do { __builtin_amdgcn_s_setprio(1); _Pragma("unroll") for (int m = 0; m < 4; ++m) _Pragma("unroll") for (int n = 0; n < 2; ++n) _Pragma("unroll") for (int k = 0; k < 2; ++k) \
        acc[ai][bj][m][n] = __builtin_amdgcn_mfma_f32_16x16x32_bf16(Bt[n][k], At[m][k], acc[ai][bj][m][n], 0, 0, 0); __builtin_amdgcn_s_setprio(0); } while (0)
#define PG8_WAIT_V(n) asm volatile("s_waitcnt vmcnt(" #n ")" ::: "memory")
#define PG8_WAIT_L(n) asm volatile("s_waitcnt lgkmcnt(" #n ")" ::: "memory")
#define PG8_BAR __builtin_amdgcn_s_barrier()
#define PG8_SCHED __builtin_amdgcn_sched_barrier(0)
    Unit cur, nxt; int ui = 0;
    if (!S.next(0, cur)) return;
    f32x4 acc[2][2][4][2];
#pragma unroll
    for (int a = 0; a < 2; ++a)
#pragma unroll
        for (int b = 0; b < 2; ++b)
#pragma unroll
            for (int m = 0; m < 4; ++m)
#pragma unroll
                for (int n = 0; n < 2; ++n) acc[a][b][m][n] = (f32x4){0.f, 0.f, 0.f, 0.f};
    bf16x8 At[4][2], B0[2][2], B1[2][2];
    const char* cA = (const char*)g.A + (size_t)cur.pm * tstep; const char* cB = (const char*)g.Bt + (size_t)cur.pn * tstep;
    S.a_ready(cur);
    if constexpr (SP2) {
        PG8_STAGE(PG8_SB(0, 0), cB, voffB); PG8_STAGE(PG8_SB(0, 1), cB + hstep, voffB); PG8_STAGE(PG8_SA(0, 0), cA, voffA); PG8_STAGE(PG8_SA(0, 1), cA + hstep, voffA);
        if (wr == 1) PG8_BAR;
        PG8_WAIT_V(2); PG8_BAR;
        PG8_STAGE(PG8_SB(1, 0), cB + kstep, voffB); PG8_STAGE(PG8_SA(1, 0), cA + kstep, voffA); PG8_STAGE(PG8_SB(1, 1), cB + hstep + kstep, voffB);
        PG8_WAIT_V(6); PG8_BAR;
    } else {
        PG8_STAGE(PG8_SB(0, 0), cB, voffB); PG8_STAGE(PG8_SA(0, 0), cA, voffA); PG8_STAGE(PG8_SB(0, 1), cB + hstep, voffB); PG8_STAGE(PG8_SA(0, 1), cA + hstep, voffA);
        if (wr == 1) PG8_BAR;
        PG8_WAIT_V(4); PG8_BAR;
        PG8_STAGE(PG8_SB(1, 0), cB + kstep, voffB); PG8_STAGE(PG8_SA(1, 0), cA + kstep, voffA); PG8_STAGE(PG8_SB(1, 1), cB + hstep + kstep, voffB);
        PG8_WAIT_V(6); PG8_BAR;
    }
    for (;;) {
        const bool has_next = S.next(ui + 1, nxt);
        const char* nA = has_next ? (const char*)g.A + (size_t)nxt.pm * tstep : cA; const char* nB = has_next ? (const char*)g.Bt + (size_t)nxt.pn * tstep : cB;
        for (int t = 0; t < nt; t += 2) {
            const bool last = (t == nt - 2);
            const char* a1 = cA + (size_t)(t + 1) * kstep;
            const char* a2 = last ? nA : cA + (size_t)(t + 2) * kstep; const char* b2 = last ? nB : cB + (size_t)(t + 2) * kstep;
            const char* a3 = a2 + kstep; const char* b3 = b2 + kstep;
            if (last && has_next) S.a_ready(nxt);
            if constexpr (SP2) {
            PG8_LDB(B0, 0, 0); PG8_LDB(B1, 0, 1); PG8_SCHED; PG8_LDA(At, 0, 0); PG8_STAGE(PG8_SA(1, 1), a1 + hstep, voffA);
            PG8_WAIT_V(8); PG8_WAIT_L(0); PG8_BAR; PG8_MMA(0, 0, At, B0); PG8_MMA(0, 1, At, B1); PG8_BAR; PG8_SCHED;
            PG8_LDA(At, 0, 1); PG8_STAGE(PG8_SB(0, 0), b2, voffB); PG8_STAGE(PG8_SB(0, 1), b2 + hstep, voffB); PG8_STAGE(PG8_SA(0, 0), a2, voffA);
            PG8_WAIT_V(8); PG8_WAIT_L(0); PG8_BAR; PG8_MMA(1, 0, At, B0); PG8_MMA(1, 1, At, B1); PG8_BAR; PG8_SCHED;
            PG8_LDB(B0, 1, 0); PG8_LDB(B1, 1, 1); PG8_SCHED; PG8_LDA(At, 1, 0); PG8_STAGE(PG8_SA(0, 1), a2 + hstep, voffA);
            PG8_WAIT_V(8); PG8_WAIT_L(0); PG8_BAR; PG8_MMA(0, 0, At, B0); PG8_MMA(0, 1, At, B1); PG8_BAR; PG8_SCHED;
            PG8_LDA(At, 1, 1); PG8_STAGE(PG8_SB(1, 0), b3, voffB); PG8_STAGE(PG8_SB(1, 1), b3 + hstep, voffB); PG8_STAGE(PG8_SA(1, 0), a3, voffA);
            PG8_WAIT_V(8); PG8_WAIT_L(0); PG8_BAR; PG8_MMA(1, 0, At, B0); PG8_MMA(1, 1, At, B1); PG8_BAR; PG8_SCHED;
            } else {
            PG8_LDB(B0, 0, 0); PG8_SCHED; PG8_LDA(At, 0, 0); PG8_STAGE(PG8_SA(1, 1), a1 + hstep, voffA);
            PG8_WAIT_L(8); PG8_BAR; PG8_WAIT_L(0); PG8_MMA(0, 0, At, B0); PG8_BAR; PG8_SCHED;
            PG8_LDB(B1, 0, 1); PG8_STAGE(PG8_SB(0, 0), b2, voffB);
            PG8_BAR; PG8_WAIT_L(0); PG8_MMA(0, 1, At, B1); PG8_BAR;
            PG8_LDA(At, 0, 1); PG8_STAGE(PG8_SA(0, 0), a2, voffA);
            PG8_BAR; PG8_WAIT_L(0); PG8_MMA(1, 0, At, B0); PG8_BAR; PG8_SCHED;
            PG8_STAGE(PG8_SB(0, 1), b2 + hstep, voffB);
            PG8_WAIT_V(6); PG8_BAR; PG8_MMA(1, 1, At, B1); PG8_BAR;
            PG8_LDB(B0, 1, 0); PG8_SCHED; PG8_LDA(At, 1, 0); PG8_STAGE(PG8_SA(0, 1), a2 + hstep, voffA);
            PG8_WAIT_L(8); PG8_BAR; PG8_WAIT_L(0); PG8_MMA(0, 0, At, B0); PG8_BAR; PG8_SCHED;
            PG8_LDB(B1, 1, 1); PG8_STAGE(PG8_SB(1, 0), b3, voffB);
            PG8_BAR; PG8_WAIT_L(0); PG8_MMA(0, 1, At, B1); PG8_BAR;
            PG8_LDA(At, 1, 1); PG8_STAGE(PG8_SA(1, 0), a3, voffA);
            PG8_BAR; PG8_WAIT_L(0); PG8_MMA(1, 0, At, B0); PG8_BAR; PG8_SCHED;
            PG8_STAGE(PG8_SB(1, 1), b3 + hstep, voffB);
            PG8_WAIT_V(6); PG8_BAR; PG8_MMA(1, 1, At, B1); PG8_BAR;
            }
        }
        if constexpr (ALIGN_EPI) { if (wr == 0) PG8_BAR; }
        if constexpr (!Epi::AFTER_DRAIN) { E(acc, cur, wr, wc, fr, fq); S.done(cur); }
        if (!has_next) break;
#pragma unroll
        for (int a = 0; a < 2; ++a)
#pragma unroll
            for (int b = 0; b < 2; ++b)
#pragma unroll
                for (int m = 0; m < 4; ++m)
#pragma unroll
                    for (int n = 0; n < 2; ++n) acc[a][b][m][n] = (f32x4){0.f, 0.f, 0.f, 0.f};
        cur = nxt; cA = nA; cB = nB; ++ui;
        if constexpr (ALIGN_EPI) { if (wr == 1) PG8_BAR; }
    }
    PG8_WAIT_V(0);
    if constexpr (!ALIGN_EPI) { if (wr == 0) PG8_BAR; }
    PG8_BAR;
    if constexpr (Epi::AFTER_DRAIN) { E.fused(acc, cur, wr, wc, fr, fq, lds, wid, lane); S.done(cur); }
#undef PG8_SA
#undef PG8_SB
#undef PG8_STAGE
#undef PG8_LDA
#undef PG8_LDB
#undef PG8_MMA
#undef PG8_WAIT_V
#undef PG8_WAIT_L
#undef PG8_BAR
#undef PG8_SCHED
}
}

constexpr int DM = 2048, NCTX = 4096, NLAT = 8192, MTOK = 12288, DEPTH = 4, DIN = 4608, DFF = 8192, NMODW = 12288;
constexpr int CTX_B = 16, CTX_T = 256, LAT_B = 8, LAT_T = 1024, PAST = 256;
constexpr int C_NAQ = 0, C_NAK = 512, C_NAV = 1024, C_GQ = 1536, C_GK = 2560, C_GV = 2816, C_DQ = 3072, C_DK = 3584, C_DV = 4096;
constexpr int AO_NA = 0, AO_G = 512, AO_D = 1536;
constexpr float EPS = 1e-6f;
constexpr size_t OUT_X = 0, OUT_NAK = 25165824, OUT_NAV = OUT_NAK + 8388608, OUT_GK = OUT_NAV + 8388608, OUT_GV = OUT_GK + 4194304, OUT_DK = OUT_GV + 4194304, OUT_DV = OUT_DK + 8388608, OUT_END = OUT_DV + 8388608;
static_assert(OUT_END == 67108864, "out map");
constexpr size_t MiB = 1u << 20;
constexpr size_t WS_CTL = 0, CTL_ZERO_BYTES = 1 * MiB;
constexpr size_t WS_MOD = 1 * MiB;
constexpr size_t WS_ROPE = 3 * MiB;
constexpr size_t WS_WIN = 4 * MiB;
constexpr size_t WS_WOUT = 76 * MiB;
constexpr size_t WS_WUP = 108 * MiB;
constexpr size_t WS_WDN = 236 * MiB;
constexpr size_t WS_H = 364 * MiB;
constexpr size_t WS_QKV = 412 * MiB;
constexpr size_t WS_AO = 520 * MiB;
constexpr size_t WS_O2 = 568 * MiB;
constexpr size_t WS_U = 664 * MiB;
constexpr size_t WS_CNAK = 856 * MiB, WS_CNAV = 864 * MiB, WS_CGK = 872 * MiB, WS_CGV = 876 * MiB, WS_CDK = 880 * MiB, WS_CDV = 888 * MiB;
constexpr size_t WS_END = 896 * MiB;
constexpr int CW_BAR = 4096;

constexpr int RING_OFF = 0, RING_BYTES = 131072;
constexpr int LDSCTL_OFF = RING_BYTES, MISC_OFF = LDSCTL_OFF + 320;
constexpr int LDS_BYTES = 147456;
constexpr int NWAVES = 8, NTHREADS = 512;

#define GAS __attribute__((address_space(1)))
#define LAS __attribute__((address_space(3)))
typedef unsigned short bf16;
typedef unsigned v4u __attribute__((ext_vector_type(4)));
typedef unsigned v2u __attribute__((ext_vector_type(2)));
typedef float f32x4 __attribute__((ext_vector_type(4)));
typedef float f32x2 __attribute__((ext_vector_type(2)));
#define LDS_WAIT() asm volatile("s_waitcnt lgkmcnt(0)" ::: "memory")
#define VM_WAIT() asm volatile("s_waitcnt vmcnt(0)" ::: "memory")
__device__ __forceinline__ unsigned f2bf(float f) { unsigned u = __builtin_bit_cast(unsigned, f); return (u + 0x7fffu + ((u >> 16) & 1u)) >> 16; }
__device__ __forceinline__ unsigned pk2(float lo, float hi) { return f2bf(lo) | (f2bf(hi) << 16); }
__device__ __forceinline__ float bf_lo(unsigned u) { return __builtin_bit_cast(float, u << 16); }
__device__ __forceinline__ float bf_hi(unsigned u) { return __builtin_bit_cast(float, u & 0xffff0000u); }
__device__ __forceinline__ float wave_sum(float v) {
#pragma unroll
    for (int o = 1; o < 64; o <<= 1) v += __shfl_xor(v, o);
    return v;
}
__device__ __forceinline__ float half_sum(float v) {
#pragma unroll
    for (int o = 1; o < 32; o <<= 1) v += __shfl_xor(v, o);
    return v;
}

struct Args { const float* in[22]; float* out; unsigned char* ws; int ph_lo, ph_hi; };
typedef const __attribute__((address_space(4))) Args CArgs;
__device__ __forceinline__ CArgs* args_here() { CArgs* p = (CArgs*)__builtin_amdgcn_kernarg_segment_ptr(); asm volatile("" : "+s"(p)); return p; }
enum { I_XP = 0, I_XS, I_C, I_CNAK, I_CNAV, I_CGK, I_CGV, I_CDK, I_CDV, I_CCTX, I_WADA, I_BADA, I_NORMG, I_WIN, I_WOUT, I_RPB, I_QG, I_KG, I_LAM, I_DG, I_WUP, I_WDN };

#define XB_TMO      128
#define XB_XCNT(j)  (256  + 64 * (j))
#define XB_XSUB(j)  (1280 + 64 * (j))
#define XB_XGEN(j)  (2304 + 64 * (j))
#define XB_TOP      3328
#define XB_TOPGEN   3392
#define XCD_BAR_WORDS 3456
#define XB_SPIN_CAP (1u << 18)

__device__ __forceinline__ unsigned xb_ld(unsigned* p)              { return __hip_atomic_load(p, __ATOMIC_RELAXED, __HIP_MEMORY_SCOPE_AGENT); }
__device__ __forceinline__ unsigned xb_add(unsigned* p, unsigned v) { return __hip_atomic_fetch_add(p, v, __ATOMIC_RELAXED, __HIP_MEMORY_SCOPE_AGENT); }
__device__ __forceinline__ unsigned xb_xcc_id() { return (unsigned)__builtin_amdgcn_s_getreg((3 << 11) | 20) & 0xFu; }
#define XB_SPIN(cond, bar) do { unsigned _sp = 0; while (cond) { __builtin_amdgcn_s_sleep(1); \
    if ((++_sp & 255u) == 0u) { if (xb_ld(&(bar)[XB_TMO])) break; if (_sp > XB_SPIN_CAP) { atomicAdd(&(bar)[XB_TMO], 1u); break; } } } } while (0)

struct XcdBarrier {
    unsigned* bar; unsigned x;
    volatile LAS unsigned* st;
};

__device__ __forceinline__ XcdBarrier xcd_barrier_post(unsigned* bar, volatile LAS unsigned* st) {
    XcdBarrier b; b.bar = bar; b.x = xb_xcc_id(); b.st = st;
    if (threadIdx.x == 0) (void)xb_add(&bar[XB_XCNT(b.x)], 1u);
    return b;
}
__device__ __forceinline__ void xcd_barrier_complete(unsigned* bar, unsigned x, unsigned& nloc, unsigned& nx) {
    const unsigned G = gridDim.x * gridDim.y * gridDim.z;
    unsigned sum, cnt, mine, sp = 0u;
    for (;;) {
        sum = 0u; cnt = 0u; mine = 0u;
#pragma unroll
        for (unsigned j = 0; j < 16; ++j) { const unsigned c = xb_ld(&bar[XB_XCNT(j)]); sum += c; cnt += (c > 0u) ? 1u : 0u; mine = (j == x) ? c : mine; }
        if (sum == G) break;
        __builtin_amdgcn_s_sleep(1);
        if ((++sp & 255u) == 0u) { if (xb_ld(&bar[XB_TMO])) break; if (sp > XB_SPIN_CAP) { atomicAdd(&bar[XB_TMO], 1u); break; } }
    }
    nloc = mine > 0u ? mine : 1u; nx = cnt > 0u ? cnt : 1u;
}

__device__ __forceinline__ void xcd_barrier(const XcdBarrier& b) {
    asm volatile("s_waitcnt vmcnt(0)" ::: "memory");
    __syncthreads();
    if (threadIdx.x == 0) {
        unsigned* bar = b.bar;
        __builtin_amdgcn_s_waitcnt(0);
        unsigned nloc = b.st[0], nx = b.st[1];
        if (nloc == 0u) { xcd_barrier_complete(bar, b.x, nloc, nx); b.st[0] = nloc; b.st[1] = nx; }
        const unsigned old = xb_add(&bar[XB_XSUB(b.x)], 1u);
        const unsigned gen = old / nloc;
        if (old + 1u == (gen + 1u) * nloc) {
            __builtin_amdgcn_fence(__ATOMIC_RELEASE, "agent");
            asm volatile("s_waitcnt vmcnt(0)" ::: "memory");
            const unsigned og = xb_add(&bar[XB_TOP], 1u);
            const unsigned tg = og / nx;
            if (og + 1u == (tg + 1u) * nx) xb_add(&bar[XB_TOPGEN], 1u);
            else XB_SPIN(xb_ld(&bar[XB_TOPGEN]) == tg, bar);
            __builtin_amdgcn_fence(__ATOMIC_ACQUIRE, "agent");
            xb_add(&bar[XB_XGEN(b.x)], 1u);
            asm volatile("s_waitcnt vmcnt(0)" ::: "memory");
        } else {
            XB_SPIN(xb_ld(&bar[XB_XGEN(b.x)]) == gen, bar);
            __builtin_amdgcn_fence(__ATOMIC_ACQUIRE, "agent");
            asm volatile("s_waitcnt vmcnt(0)" ::: "memory");
        }
    }
    __syncthreads();
}
struct Ctx { LAS unsigned char* lds; int tid, lane, wave, vcu, G, gw, NGW; };

__device__ __forceinline__ void p0_transpose_item(const float* W, int K, int N, bf16* WT, LAS float* scr, int item, int lane) {
    const int nblk = N / 32, kb = item / nblk, nb = item % nblk, k0 = 64 * kb, n0 = 32 * nb;
#pragma unroll 8
    for (int i = 0; i < 32; ++i) { const int kk = 2 * i + (lane >> 5); scr[kk * 33 + (lane & 31)] = W[(size_t)(k0 + kk) * N + n0 + (lane & 31)]; }
    LDS_WAIT(); asm volatile("" ::: "memory");
    const int c = lane & 7;
#pragma unroll
    for (int j = 0; j < 4; ++j) { const int n = (lane >> 3) + 8 * j; const LAS float* s = scr + (8 * c) * 33 + n;
        v4u o; o.x = pk2(s[0 * 33], s[1 * 33]); o.y = pk2(s[2 * 33], s[3 * 33]); o.z = pk2(s[4 * 33], s[5 * 33]); o.w = pk2(s[6 * 33], s[7 * 33]);
        *(GAS v4u*)(WT + (size_t)(n0 + n) * K + k0 + 8 * c) = o; }
    LDS_WAIT(); asm volatile("" ::: "memory");
}

__device__ __forceinline__ void cvt_tensor(const float* src, bf16* dst, size_t n8, size_t gt, size_t NT) {
    for (size_t i = gt; i < n8; i += NT) { const f32x4 a = *(const f32x4*)(src + i * 8), b = *(const f32x4*)(src + i * 8 + 4);
        v4u o; o.x = pk2(a.x, a.y); o.y = pk2(a.z, a.w); o.z = pk2(b.x, b.y); o.w = pk2(b.z, b.w); *(v4u*)(dst + i * 8) = o; }
}

__device__ __forceinline__ void ph_prologue(CArgs* a, const Ctx& X) {
    unsigned char* ws = a->ws;
#ifndef PROMASK
#define PROMASK 15
#endif
    if (PROMASK & 1)
    {
        constexpr int SLW = 2176;
        LAS float* sl = (LAS float*)X.lds; LAS float* red = (LAS float*)(X.lds + 9 * SLW * 4);
        const float* cin = a->in[I_C]; const float* cctx = a->in[I_CCTX];
        for (int i = X.tid; i < 9 * 2048; i += NTHREADS) { const int v = i >> 11, k = i & 2047; const float x = (v < 8) ? cin[v * 2048 + k] : cctx[k];
            sl[v * SLW + k + 4 * (k >> 6)] = x / (1.0f + expf(-x)); }
        __syncthreads();
        float* mod = (float*)(ws + WS_MOD); const float* wada = a->in[I_WADA]; const float* bada = a->in[I_BADA];
        const int kq = X.tid >> 4, cg = X.tid & 15, k0 = kq * 64;
        for (int item = X.vcu; item < DEPTH * 192; item += X.G) {
            const int l = item / 192, n0 = (item % 192) * 64;
            const float* W = wada + (size_t)l * DM * NMODW + n0 + 4 * cg;
            f32x4 acc[9];
#pragma unroll
            for (int v = 0; v < 9; ++v) acc[v] = (f32x4){0.f, 0.f, 0.f, 0.f};
#pragma unroll 1
            for (int kk = 0; kk < 64; kk += 4) {
                const f32x4 w0 = *(const f32x4*)(W + (size_t)(k0 + kk) * NMODW), w1 = *(const f32x4*)(W + (size_t)(k0 + kk + 1) * NMODW),
                            w2 = *(const f32x4*)(W + (size_t)(k0 + kk + 2) * NMODW), w3 = *(const f32x4*)(W + (size_t)(k0 + kk + 3) * NMODW);
#pragma unroll
                for (int v = 0; v < 9; ++v) { const f32x4 s = *(const LAS f32x4*)(sl + v * SLW + k0 + kk + 4 * kq);
                    acc[v] += w0 * s.x + w1 * s.y + w2 * s.z + w3 * s.w; }
            }
#pragma unroll
            for (int v = 0; v < 9; ++v)
#pragma unroll
                for (int j = 0; j < 4; ++j) { float t = acc[v][j]; t += __shfl_xor(t, 16); t += __shfl_xor(t, 32); acc[v][j] = t; }
            if (X.lane < 16) {
#pragma unroll
                for (int v = 0; v < 9; ++v) *(LAS f32x4*)(red + (X.wave * 9 + v) * 64 + 4 * X.lane) = acc[v];
            }
            __syncthreads();
            for (int o = X.tid; o < 576; o += NTHREADS) { const int v = o >> 6, cc = o & 63; float s = 0.f;
#pragma unroll
                for (int w = 0; w < 8; ++w) s += red[(w * 9 + v) * 64 + cc];
                mod[(size_t)(l * 9 + v) * NMODW + n0 + cc] = s + bada[l * NMODW + n0 + cc]; }
            __syncthreads();
        }
    }
    if (PROMASK & 2)
    {
        LAS float* scr = (LAS float*)(X.lds + RING_OFF + X.wave * 16384);
        constexpr int I_IN = (DM / 64) * (DIN / 32), I_OUT = (DM / 64) * (DM / 32), I_UP = (DM / 64) * (DFF / 32), I_DN = (DFF / 64) * (DM / 32);
        constexpr int PER_L = I_IN + I_OUT + I_UP + I_DN;
        for (int it = X.gw; it < DEPTH * PER_L; it += X.NGW) {
            const int l = it / PER_L; int r = it % PER_L;
            if (r < I_IN) { p0_transpose_item(a->in[I_WIN] + (size_t)l * DM * DIN, DM, DIN, (bf16*)(ws + WS_WIN) + (size_t)l * DIN * DM, scr, r, X.lane); continue; } r -= I_IN;
            if (r < I_OUT) { p0_transpose_item(a->in[I_WOUT] + (size_t)l * DM * DM, DM, DM, (bf16*)(ws + WS_WOUT) + (size_t)l * DM * DM, scr, r, X.lane); continue; } r -= I_OUT;
            if (r < I_UP) { p0_transpose_item(a->in[I_WUP] + (size_t)l * DM * DFF, DM, DFF, (bf16*)(ws + WS_WUP) + (size_t)l * DFF * DM, scr, r, X.lane); continue; } r -= I_UP;
            p0_transpose_item(a->in[I_WDN] + (size_t)l * DFF * DM, DFF, DM, (bf16*)(ws + WS_WDN) + (size_t)l * DM * DFF, scr, r, X.lane);
        }
    }
    if (PROMASK & 4)
    {
        f32x2* rope = (f32x2*)(ws + WS_ROPE);
        for (int i = X.vcu * NTHREADS + X.tid; i < 64 * 48; i += X.G * NTHREADS) { const int pos = i / 48, f = i % 48;
            const double e = (f < 32) ? (double)f / 32.0 : (double)(f - 32) / 16.0;
            const float inv = (float)exp(-9.210340371976184 * e); const float ang = (float)pos * inv;
            const double ad = (double)ang; const double nq = __builtin_rint(ad * 0.6366197723675814); const double r = ad - nq * 1.5707963267948966, r2 = r * r;
            const double sr = r * (1.0 + r2 * (-1.0 / 6 + r2 * (1.0 / 120 + r2 * (-1.0 / 5040 + r2 * (1.0 / 362880 + r2 * (-1.0 / 39916800 + r2 * (1.0 / 6227020800.0)))))));
            const double cr = 1.0 + r2 * (-0.5 + r2 * (1.0 / 24 + r2 * (-1.0 / 720 + r2 * (1.0 / 40320 + r2 * (-1.0 / 3628800 + r2 * (1.0 / 479001600 + r2 * (-1.0 / 87178291200.0)))))));
            const int q = ((int)nq) & 3;
            const double cv = (q == 0) ? cr : (q == 1) ? -sr : (q == 2) ? -cr : sr, sv = (q == 0) ? sr : (q == 1) ? cr : (q == 2) ? -sr : -cr;
            rope[i] = (f32x2){(float)cv, (float)sv}; }
    }
    if (PROMASK & 8)
    {
        const size_t gt = (size_t)X.vcu * NTHREADS + X.tid, NT = (size_t)X.G * NTHREADS;
        cvt_tensor(a->in[I_CNAK], (bf16*)(ws + WS_CNAK), (size_t)LAT_B * DEPTH * PAST * 512 / 8, gt, NT);
        cvt_tensor(a->in[I_CNAV], (bf16*)(ws + WS_CNAV), (size_t)LAT_B * DEPTH * PAST * 512 / 8, gt, NT);
        cvt_tensor(a->in[I_CGK], (bf16*)(ws + WS_CGK), (size_t)LAT_B * DEPTH * PAST * 256 / 8, gt, NT);
        cvt_tensor(a->in[I_CGV], (bf16*)(ws + WS_CGV), (size_t)LAT_B * DEPTH * PAST * 256 / 8, gt, NT);
        cvt_tensor(a->in[I_CDK], (bf16*)(ws + WS_CDK), (size_t)LAT_B * DEPTH * PAST * 512 / 8, gt, NT);
        cvt_tensor(a->in[I_CDV], (bf16*)(ws + WS_CDV), (size_t)LAT_B * DEPTH * PAST * 512 / 8, gt, NT);
    }
}

__device__ __forceinline__ int mod_vec(int m) { return m < NCTX ? 8 : ((m - NCTX) >> 10); }

template <bool UPD, bool FIRST>
__device__ __forceinline__ void norm_rows(CArgs* a, const Ctx& X, const float* o2, const float* g_post, const float* mod_gate, int gate_off,
                                          const float* g_pre, const float* mod_next, int sh_off, int sc_off, bool write_h) {
    float* xbuf = a->out; bf16* H = (bf16*)(a->ws + WS_H);
    for (int m = X.gw; m < MTOK; m += X.NGW) {
        const int mv = mod_vec(m);
        f32x4 x[8];
        if (FIRST) { const float* src = (m < NCTX) ? a->in[I_XP] + (size_t)m * DM : a->in[I_XS] + (size_t)(m - NCTX) * DM;
#pragma unroll
            for (int j = 0; j < 8; ++j) x[j] = *(const f32x4*)(src + 4 * X.lane + 256 * j);
        } else {
#pragma unroll
            for (int j = 0; j < 8; ++j) x[j] = *(const f32x4*)(xbuf + (size_t)m * DM + 4 * X.lane + 256 * j);
        }
        if (UPD) {
            f32x4 o[8]; float ss = 0.f;
#pragma unroll
            for (int j = 0; j < 8; ++j) { o[j] = *(const f32x4*)(o2 + (size_t)m * DM + 4 * X.lane + 256 * j); ss += (o[j].x * o[j].x + o[j].y * o[j].y) + (o[j].z * o[j].z + o[j].w * o[j].w); }
            const float r1 = 1.0f / sqrtf(wave_sum(ss) * (1.0f / DM) + EPS);
#pragma unroll
            for (int j = 0; j < 8; ++j) { const int col = 4 * X.lane + 256 * j;
                const f32x4 gp = *(const f32x4*)(g_post + col), gt = *(const f32x4*)(mod_gate + (size_t)mv * NMODW + gate_off + col);
                x[j] = x[j] + gt * ((o[j] * r1) * gp); }
        }
        if (UPD || FIRST) {
#pragma unroll
            for (int j = 0; j < 8; ++j) *(f32x4*)(xbuf + (size_t)m * DM + 4 * X.lane + 256 * j) = x[j];
        }
        if (write_h) {
            float ss = 0.f;
#pragma unroll
            for (int j = 0; j < 8; ++j) ss += (x[j].x * x[j].x + x[j].y * x[j].y) + (x[j].z * x[j].z + x[j].w * x[j].w);
            const float r2 = 1.0f / sqrtf(wave_sum(ss) * (1.0f / DM) + EPS);
#pragma unroll
            for (int j = 0; j < 8; ++j) { const int col = 4 * X.lane + 256 * j;
                const f32x4 g = *(const f32x4*)(g_pre + col), sc = *(const f32x4*)(mod_next + (size_t)mv * NMODW + sc_off + col), sh = *(const f32x4*)(mod_next + (size_t)mv * NMODW + sh_off + col);
                const f32x4 h = ((x[j] * r2) * g) * (sc + 1.0f) + sh;
                v2u w; w.x = pk2(h.x, h.y); w.y = pk2(h.z, h.w); *(v2u*)(H + (size_t)m * DM + col) = w; }
        }
    }
}

__device__ __forceinline__ void ph_fixup(CArgs* a, const Ctx& X, int l) {
    bf16* QKV = (bf16*)(a->ws + WS_QKV); const f32x2* rope = (const f32x2*)(a->ws + WS_ROPE);
    const int lane = X.lane;
    const float qg0 = a->in[I_QG][l * 128 + 2 * lane], qg1 = a->in[I_QG][l * 128 + 2 * lane + 1];
    const float kg0 = a->in[I_KG][l * 128 + 2 * lane], kg1 = a->in[I_KG][l * 128 + 2 * lane + 1];
    for (int m = X.gw; m < MTOK; m += X.NGW) {
        bf16* row = QKV + (size_t)m * DIN;
        const bool lat = m >= NCTX; const int t = (m - NCTX) & 1023, prow = t >> 6, pcol = t & 63;
        const int cb = m >> 8, ct = m & 255;
        for (int hh = 0; hh < 10; ++hh) {
            const int col = hh < 8 ? C_GQ + hh * 128 : C_GK + (hh - 8) * 128;
            const unsigned u = *(const unsigned*)(row + col + 2 * lane); float x0 = bf_lo(u), x1 = bf_hi(u);
            const float r = 1.0f / sqrtf(wave_sum(x0 * x0 + x1 * x1) * (1.0f / 128.0f) + EPS);
            x0 = x0 * r * (hh < 8 ? qg0 : kg0); x1 = x1 * r * (hh < 8 ? qg1 : kg1);
            if (lat) {
                const int pos = (lane < 32) ? prow : pcol, fi = (2 * lane) & 31;
                const f32x2 cs0 = rope[pos * 48 + fi], cs1 = rope[pos * 48 + fi + 1];
                const float p0 = __shfl_xor(x0, 16), p1 = __shfl_xor(x1, 16), sg = (lane & 16) ? 1.0f : -1.0f;
                x0 = x0 * cs0.x + sg * p0 * cs0.y; x1 = x1 * cs1.x + sg * p1 * cs1.y;
            }
            *(unsigned*)(row + col + 2 * lane) = pk2(x0, x1);
            if (!lat && hh >= 8) *(f32x2*)(a->out + OUT_GK + ((size_t)(cb * DEPTH + l) * CTX_T + ct) * 256 + (hh - 8) * 128 + 2 * lane) = (f32x2){x0, x1};
        }
        if (lat) {
            for (int hh = 0; hh < 8; ++hh) {
                const int col = hh < 4 ? C_DQ + hh * 128 : C_DK + (hh - 4) * 128;
                const unsigned u = *(const unsigned*)(row + col + 2 * lane); float x0 = bf_lo(u), x1 = bf_hi(u);
                const int pos = (lane & 16) ? pcol : prow, fi = 32 + ((2 * lane) & 15);
                const f32x2 cs0 = rope[pos * 48 + fi], cs1 = rope[pos * 48 + fi + 1];
                const float p0 = __shfl_xor(x0, 8), p1 = __shfl_xor(x1, 8), sg = (lane & 8) ? 1.0f : -1.0f;
                x0 = x0 * cs0.x + sg * p0 * cs0.y; x1 = x1 * cs1.x + sg * p1 * cs1.y;
                *(unsigned*)(row + col + 2 * lane) = pk2(x0, x1);
            }
        } else {
            const size_t r5 = ((size_t)(cb * DEPTH + l) * CTX_T + ct) * 512, r2 = ((size_t)(cb * DEPTH + l) * CTX_T + ct) * 256;
#pragma unroll
            for (int j = 0; j < 4; ++j) {
                unsigned u = *(const unsigned*)(row + C_NAK + j * 128 + 2 * lane); *(f32x2*)(a->out + OUT_NAK + r5 + j * 128 + 2 * lane) = (f32x2){bf_lo(u), bf_hi(u)};
                u = *(const unsigned*)(row + C_NAV + j * 128 + 2 * lane); *(f32x2*)(a->out + OUT_NAV + r5 + j * 128 + 2 * lane) = (f32x2){bf_lo(u), bf_hi(u)};
                u = *(const unsigned*)(row + C_DK + j * 128 + 2 * lane); *(f32x2*)(a->out + OUT_DK + r5 + j * 128 + 2 * lane) = (f32x2){bf_lo(u), bf_hi(u)};
                u = *(const unsigned*)(row + C_DV + j * 128 + 2 * lane); *(f32x2*)(a->out + OUT_DV + r5 + j * 128 + 2 * lane) = (f32x2){bf_lo(u), bf_hi(u)};
            }
#pragma unroll
            for (int j = 0; j < 2; ++j) { const unsigned u = *(const unsigned*)(row + C_GV + j * 128 + 2 * lane); *(f32x2*)(a->out + OUT_GV + r2 + j * 128 + 2 * lane) = (f32x2){bf_lo(u), bf_hi(u)}; }
        }
    }
}

__device__ __forceinline__ float lambda_init_of(int l) { return 0.8f - 0.6f * expf(-0.3f * (float)l); }

struct SmState { float m, l, o0, o1; };
__device__ __forceinline__ void sm_step(SmState& S, float s, float v0, float v1) {
    const float mn = fmaxf(S.m, s), al = __expf(S.m - mn), p = __expf(s - mn);
    S.l = S.l * al + p; S.o0 = S.o0 * al + p * v0; S.o1 = S.o1 * al + p * v1; S.m = mn;
}
__device__ __forceinline__ void ph_attn_naive(CArgs* a, const Ctx& X, int l) {
    const bf16* QKV = (const bf16*)(a->ws + WS_QKV); bf16* AO = (bf16*)(a->ws + WS_AO);
    const int lane = X.lane;
    const float li = lambda_init_of(l);
    const float* lamv = a->in[I_LAM] + l * 256;
    const float lam = expf(wave_sum(lamv[lane] * lamv[64 + lane])) - expf(wave_sum(lamv[128 + lane] * lamv[192 + lane])) + li;
    const float dg0 = a->in[I_DG][l * 128 + 2 * lane], dg1 = a->in[I_DG][l * 128 + 2 * lane + 1];
    for (int item = X.gw; item < MTOK * 16; item += X.NGW) {
        const int m = item >> 4, hu = item & 15; const bool lat = m >= NCTX;
        const bf16* qrow = QKV + (size_t)m * DIN;
        if (hu < 12) {
            int qc, kc, vc, ocol, cw, ch; const bf16 *ck, *cv;
            if (hu < 4) { qc = C_NAQ + hu * 128; kc = C_NAK + hu * 128; vc = C_NAV + hu * 128; ocol = AO_NA + hu * 128; cw = 512; ch = hu; ck = (const bf16*)(a->ws + WS_CNAK); cv = (const bf16*)(a->ws + WS_CNAV); }
            else { const int hq = hu - 4, kvh = hq >> 2; qc = C_GQ + hq * 128; kc = C_GK + kvh * 128; vc = C_GV + kvh * 128; ocol = AO_G + hq * 128; cw = 256; ch = kvh; ck = (const bf16*)(a->ws + WS_CGK); cv = (const bf16*)(a->ws + WS_CGV); }
            const unsigned uq = *(const unsigned*)(qrow + qc + 2 * lane); const float q0 = bf_lo(uq), q1 = bf_hi(uq);
            const float scale = 0.08838834764831845f;
            SmState S{-1e30f, 0.f, 0.f, 0.f};
            if (!lat) { const int b = m >> 8;
                for (int s = 0; s < CTX_T; ++s) { const bf16* kr = QKV + (size_t)(b * CTX_T + s) * DIN;
                    const unsigned uk = *(const unsigned*)(kr + kc + 2 * lane), uv = *(const unsigned*)(kr + vc + 2 * lane);
                    const float sc = wave_sum(q0 * bf_lo(uk) + q1 * bf_hi(uk)) * scale; sm_step(S, sc, bf_lo(uv), bf_hi(uv)); }
            } else { const int b = (m - NCTX) >> 10, t = (m - NCTX) & 1023;
                if (hu < 4) { const int rq = t >> 6, cq = t & 63; const int r0 = min(max(rq - 4, 0), 8), w0 = min(max(cq - 8, 0), 48);
                    const float* rpb = a->in[I_RPB] + (size_t)(l * 4 + hu) * 15 * 31;
                    for (int rk = r0; rk < r0 + 8; ++rk) for (int ckk = w0; ckk < w0 + 16; ++ckk) {
                        const bf16* kr = QKV + (size_t)(NCTX + b * LAT_T + rk * 64 + ckk) * DIN;
                        const unsigned uk = *(const unsigned*)(kr + kc + 2 * lane), uv = *(const unsigned*)(kr + vc + 2 * lane);
                        const float sc = wave_sum(q0 * bf_lo(uk) + q1 * bf_hi(uk)) * scale + rpb[(rk - rq + 7) * 31 + (ckk - cq + 15)]; sm_step(S, sc, bf_lo(uv), bf_hi(uv)); }
                } else {
                    for (int s = 0; s < LAT_T; ++s) { const bf16* kr = QKV + (size_t)(NCTX + b * LAT_T + s) * DIN;
                        const unsigned uk = *(const unsigned*)(kr + kc + 2 * lane), uv = *(const unsigned*)(kr + vc + 2 * lane);
                        const float sc = wave_sum(q0 * bf_lo(uk) + q1 * bf_hi(uk)) * scale; sm_step(S, sc, bf_lo(uv), bf_hi(uv)); }
                }
                for (int s = 0; s < PAST; ++s) { const size_t off = ((size_t)(b * DEPTH + l) * PAST + s) * cw + ch * 128 + 2 * lane;
                    const unsigned uk = *(const unsigned*)(ck + off), uv = *(const unsigned*)(cv + off);
                    const float sc = wave_sum(q0 * bf_lo(uk) + q1 * bf_hi(uk)) * scale; sm_step(S, sc, bf_lo(uv), bf_hi(uv)); }
            }
            const float inv = 1.0f / S.l;
            *(unsigned*)(AO + (size_t)m * DM + ocol + 2 * lane) = pk2(S.o0 * inv, S.o1 * inv);
        } else {
            const int h = hu - 12, qc = C_DQ + h * 128, kc = C_DK + h * 128, vc = C_DV + h * 128;
            const unsigned uq = *(const unsigned*)(qrow + qc + 2 * lane); const float q0 = bf_lo(uq), q1 = bf_hi(uq);
            const float scale = 0.125f;
            float mm = -1e30f, ll = 0.f;
            float a0 = 0.f, a1 = 0.f, b0 = 0.f, b1 = 0.f;
#define DIFF_STEP(uk, uv) do { const float sc = half_sum(q0 * bf_lo(uk) + q1 * bf_hi(uk)) * scale; const float mn = fmaxf(mm, sc), al = __expf(mm - mn), p = __expf(sc - mn); \
            ll = ll * al + p; mm = mn; const float al0 = __shfl(al, 0), al1 = __shfl(al, 32), p0 = __shfl(p, 0), p1 = __shfl(p, 32); const float v0 = bf_lo(uv), v1 = bf_hi(uv); \
            a0 = a0 * al0 + p0 * v0; a1 = a1 * al0 + p0 * v1; b0 = b0 * al1 + p1 * v0; b1 = b1 * al1 + p1 * v1; } while (0)
            if (!lat) { const int b = m >> 8;
                for (int s = 0; s < CTX_T; ++s) { const bf16* kr = QKV + (size_t)(b * CTX_T + s) * DIN;
                    const unsigned uk = *(const unsigned*)(kr + kc + 2 * lane), uv = *(const unsigned*)(kr + vc + 2 * lane); DIFF_STEP(uk, uv); }
            } else { const int b = (m - NCTX) >> 10;
                for (int s = 0; s < LAT_T; ++s) { const bf16* kr = QKV + (size_t)(NCTX + b * LAT_T + s) * DIN;
                    const unsigned uk = *(const unsigned*)(kr + kc + 2 * lane), uv = *(const unsigned*)(kr + vc + 2 * lane); DIFF_STEP(uk, uv); }
                const bf16* ck = (const bf16*)(a->ws + WS_CDK); const bf16* cv = (const bf16*)(a->ws + WS_CDV);
                for (int s = 0; s < PAST; ++s) { const size_t off = ((size_t)(b * DEPTH + l) * PAST + s) * 512 + h * 128 + 2 * lane;
                    const unsigned uk = *(const unsigned*)(ck + off), uv = *(const unsigned*)(cv + off); DIFF_STEP(uk, uv); }
            }
#undef DIFF_STEP
            const float l0 = __shfl(ll, 0), l1 = __shfl(ll, 32);
            float o0 = a0 / l0 - lam * (b0 / l1), o1 = a1 / l0 - lam * (b1 / l1);
            const float r = 1.0f / sqrtf(wave_sum(o0 * o0 + o1 * o1) * (1.0f / 128.0f) + EPS);
            o0 = o0 * r * dg0 * (1.0f - li); o1 = o1 * r * dg1 * (1.0f - li);
            *(unsigned*)(AO + (size_t)m * DM + AO_D + h * 128 + 2 * lane) = pk2(o0, o1);
        }
    }
}

constexpr int NPHASE = 2 + 8 * DEPTH;
#ifndef MK_SINGLE
#define MK_SINGLE 1
#endif
__global__ void __launch_bounds__(NTHREADS, 2) fwd(Args args_unused) {
    extern __shared__ __attribute__((aligned(16))) unsigned char lds_raw[];
#define CTX_HERE() Ctx X; { int t_ = threadIdx.x; asm volatile("" : "+v"(t_)); X.lds = (LAS unsigned char*)lds_raw; X.tid = t_; X.lane = t_ & 63; X.wave = __builtin_amdgcn_readfirstlane(t_ >> 6); \
    X.G = gridDim.x; const int bx_ = blockIdx.x; X.vcu = (X.G % 8 == 0) ? (bx_ % 8) * (X.G / 8) + bx_ / 8 : bx_; X.gw = X.vcu * NWAVES + X.wave; X.NGW = X.G * NWAVES; }
    LAS unsigned char* const lds0 = (LAS unsigned char*)lds_raw;
    for (int u = threadIdx.x; u < (LDS_BYTES - LDSCTL_OFF) / 4; u += NTHREADS) ((LAS unsigned*)(lds0 + LDSCTL_OFF))[u] = 0u;
    __syncthreads();
    int lo, hi; XcdBarrier bar;
    { CArgs* A = args_here(); lo = A->ph_lo; hi = A->ph_hi; unsigned* ctl = (unsigned*)(A->ws + WS_CTL);
      bar.bar = ctl + CW_BAR; bar.x = 0; bar.st = nullptr;
      if (hi - lo > 1) bar = xcd_barrier_post(ctl + CW_BAR, (volatile LAS unsigned*)(lds0 + MISC_OFF) + 8); }
#ifndef PHMASK
#define PHMASK 0xffff
#endif
#define IN(k) (lo <= (k) && (k) < hi)
#define ON(n) ((PHMASK >> (n)) & 1)
#define SEAM(k) do { if (IN(k) && IN((k) + 1)) xcd_barrier(bar); } while (0)

    if (ON(0) && IN(0)) { CTX_HERE(); CArgs* A = args_here(); ph_prologue(A, X); SEAM(0); }
    if (ON(1) && IN(1)) { CTX_HERE(); CArgs* A = args_here(); norm_rows<false, true>(A, X, nullptr, nullptr, nullptr, 0, A->in[I_NORMG], (const float*)(A->ws + WS_MOD), 0, 2048, true); SEAM(1); }

    for (int l = 0; l < DEPTH; ++l) {
        const int pb = 2 + 8 * l;
        if (ON(2) && IN(pb + 0)) {
            CArgs* A = args_here(); unsigned char* ws = A->ws;
            pg8::Gemm g{(const bf16*)(ws + WS_H), (const bf16*)(ws + WS_WIN) + (size_t)l * DIN * DM, MTOK, DIN, DM}; pg8::StaticOrder S; S.init(MTOK, DIN, (int)gridDim.x, (int)blockIdx.x);
            pg8::EpiBf16<0> E{(bf16*)(ws + WS_QKV), DIN};
            pg8::gemm_phase<pg8::EpiBf16<0>, pg8::StaticOrder, true, true>(lds0 + RING_OFF, g, S, E);
            SEAM(pb + 0);
        }
        if (ON(3) && IN(pb + 1)) { CTX_HERE(); CArgs* A = args_here(); ph_fixup(A, X, l); SEAM(pb + 1); }
        if (ON(4) && IN(pb + 2)) { CTX_HERE(); CArgs* A = args_here(); ph_attn_naive(A, X, l); SEAM(pb + 2); }
        if (ON(5) && IN(pb + 3)) {
            CArgs* A = args_here(); unsigned char* ws = A->ws;
            pg8::Gemm g{(const bf16*)(ws + WS_AO), (const bf16*)(ws + WS_WOUT) + (size_t)l * DM * DM, MTOK, DM, DM}; pg8::StaticOrder S; S.init(MTOK, DM, (int)gridDim.x, (int)blockIdx.x);
            pg8::EpiF32 E{(float*)(ws + WS_O2), DM};
            pg8::gemm_phase<pg8::EpiF32, pg8::StaticOrder, true, true>(lds0 + RING_OFF, g, S, E);
            SEAM(pb + 3);
        }
        if (ON(6) && IN(pb + 4)) { CTX_HERE(); CArgs* A = args_here(); const float* normg = A->in[I_NORMG]; const float* modl = (const float*)(A->ws + WS_MOD) + (size_t)l * 9 * NMODW;
            norm_rows<true, false>(A, X, (const float*)(A->ws + WS_O2), normg + (size_t)(l * 4 + 1) * DM, modl, 4096, normg + (size_t)(l * 4 + 2) * DM, modl, 6144, 8192, true); SEAM(pb + 4); }
        if (ON(7) && IN(pb + 5)) {
            CArgs* A = args_here(); unsigned char* ws = A->ws;
            pg8::Gemm g{(const bf16*)(ws + WS_H), (const bf16*)(ws + WS_WUP) + (size_t)l * DFF * DM, MTOK, DFF, DM}; pg8::StaticOrder S; S.init(MTOK, DFF, (int)gridDim.x, (int)blockIdx.x);
            pg8::EpiBf16<2> E{(bf16*)(ws + WS_U), DFF};
            pg8::gemm_phase<pg8::EpiBf16<2>, pg8::StaticOrder, true, true>(lds0 + RING_OFF, g, S, E);
            SEAM(pb + 5);
        }
        if (ON(8) && IN(pb + 6)) {
            CArgs* A = args_here(); unsigned char* ws = A->ws;
            pg8::Gemm g{(const bf16*)(ws + WS_U), (const bf16*)(ws + WS_WDN) + (size_t)l * DM * DFF, MTOK, DM, DFF}; pg8::StaticOrder S; S.init(MTOK, DM, (int)gridDim.x, (int)blockIdx.x);
            pg8::EpiF32 E{(float*)(ws + WS_O2), DM};
            pg8::gemm_phase<pg8::EpiF32, pg8::StaticOrder, true, true>(lds0 + RING_OFF, g, S, E);
            SEAM(pb + 6);
        }
        if (ON(9) && IN(pb + 7)) {
            CTX_HERE(); CArgs* A = args_here(); const float* normg = A->in[I_NORMG]; const float* mod_all = (const float*)(A->ws + WS_MOD);
            const int ln = (l + 1 < DEPTH) ? l + 1 : l;
            norm_rows<true, false>(A, X, (const float*)(A->ws + WS_O2), normg + (size_t)(l * 4 + 3) * DM, mod_all + (size_t)l * 9 * NMODW, 10240, normg + (size_t)(ln * 4 + 0) * DM, mod_all + (size_t)ln * 9 * NMODW, 0, 2048, l + 1 < DEPTH);
            SEAM(pb + 7);
        }
    }
#undef IN
#undef SEAM
}

extern "C" void kernel_launch(void* const* d_in, const int* in_sizes, int n_in, void* d_out, int out_size, void* d_ws, size_t ws_size, hipStream_t stream) {
    static int grid = 0;
    if (grid == 0) {
        if (n_in != 22 || out_size != (int)OUT_END || ws_size < WS_END) { fprintf(stderr, "kernel_launch: unexpected shapes: n_in %d out %d ws %zu\n", n_in, out_size, ws_size); grid = -1; return; }
        int dev = 0, cus = 0, per_cu = 0;
        if (hipGetDevice(&dev) != hipSuccess || hipDeviceGetAttribute(&cus, hipDeviceAttributeMultiprocessorCount, dev) != hipSuccess) { grid = -1; return; }
        if (hipFuncSetAttribute((const void*)fwd, hipFuncAttributeMaxDynamicSharedMemorySize, LDS_BYTES) != hipSuccess) { fprintf(stderr, "kernel_launch: hipFuncSetAttribute failed\n"); grid = -1; return; }
        if (hipOccupancyMaxActiveBlocksPerMultiprocessor(&per_cu, (const void*)fwd, NTHREADS, LDS_BYTES) != hipSuccess || per_cu < 1) fprintf(stderr, "kernel_launch: occupancy query says %d\n", per_cu);
        (void)hipGetLastError();
        grid = cus;
    }
    if (grid < 0) return;
    (void)hipMemsetAsync((char*)d_ws + WS_CTL, 0, CTL_ZERO_BYTES, stream);
    Args a{};
    for (int i = 0; i < 22; ++i) a.in[i] = (const float*)d_in[i];
    a.out = (float*)d_out; a.ws = (unsigned char*)d_ws;
#if MK_SINGLE
    a.ph_lo = 0; a.ph_hi = NPHASE;
    hipLaunchKernelGGL(fwd, dim3(grid), dim3(NTHREADS), LDS_BYTES, stream, a);
#else
    for (int p = 0; p < NPHASE; ++p) { a.ph_lo = p; a.ph_hi = p + 1; hipLaunchKernelGGL(fwd, dim3(grid), dim3(NTHREADS), LDS_BYTES, stream, a); }
#endif
    const hipError_t le = hipPeekAtLastError();
    if (le != hipSuccess) fprintf(stderr, "kernel_launch: launch failed: %s\n", hipGetErrorName(le));
}
```

```cpp
#include <hip/hip_runtime.h>
#include <cstdio>
#include <cstdint>
#include <cmath>
namespace pg8 {
#define PG8_LAS __attribute__((address_space(3)))
typedef unsigned short bf16_t;
typedef short bf16x8 __attribute__((ext_vector_type(8)));
typedef float f32x4 __attribute__((ext_vector_type(4)));
typedef unsigned u32x4 __attribute__((ext_vector_type(4)));
constexpr int BM = 256, BK = 64, HALF = 128, HTB = HALF * BK * 2  , STAGE_BYTES = 8 * HTB, NXCD = 8, WGM = 8;

__host__ __device__ __forceinline__ int lds_byte(int r, int c) { const int st = (r >> 4) * 2 + (c >> 5), rr = r & 15, cc = c & 31, ob = rr * 64 + cc * 2; return st * 1024 + (ob ^ (((ob >> 9) & 1) << 5)); }
__host__ __device__ __forceinline__ void stage_rc(int b, int& R, int& C) { const int st = b / 1024, sb = b % 1024, swz = sb ^ (((sb >> 9) & 1) << 5); R = (st >> 1) * 16 + swz / 64; C = (st & 1) * 32 + (swz % 64) / 2; }
__host__ __device__ __forceinline__ int perm32(int rho) { const int n = rho >> 4, i = rho & 15; return 8 * (i >> 2) + 4 * n + (i & 3); }

struct Unit { int pm, pn; };
struct Gemm { const bf16_t* A; const bf16_t* Bt; int M, N, K; };

struct StaticOrder {
    int nM, nN, nwg, G, c;
    __host__ __device__ void init(int M, int N, int G_, int c_) { nM = M / BM; nN = N / BM; nwg = nM * nN; G = G_; c = c_; }
    __host__ __device__ bool next(int i, Unit& u) const {
        const long L = (long)i * G + c; if (L >= nwg) return false;
        int wgid = (int)L; { const int q = nwg / NXCD, r = nwg % NXCD, xcd = wgid % NXCD, off = wgid / NXCD; wgid = (xcd < r ? xcd * (q + 1) : r * (q + 1) + (xcd - r) * q) + off; }
        const int nig = WGM * nN, gid = wgid / nig, fm = gid * WGM, gsz = (nM - fm) < WGM ? (nM - fm) : WGM;
        u.pm = fm + ((wgid % nig) % gsz); u.pn = (wgid % nig) / gsz; return true;
    }
    __device__ __forceinline__ void a_ready(const Unit&) const {}
    __device__ __forceinline__ void done(const Unit&) const {}
};

__device__ __forceinline__ unsigned cvt_pk_bf16(float lo, float hi) { unsigned r; asm volatile("v_cvt_pk_bf16_f32 %0, %1, %2" : "=v"(r) : "v"(lo), "v"(hi)); return r; }
struct EpiF32 {
    static constexpr bool PERM = false, AFTER_DRAIN = false;
    float* C; int ldc;
    __device__ __forceinline__ void operator()(const f32x4 (&acc)[2][2][4][2], const Unit& u, int wr, int wc, int fr, int fq) const {
        const int row0 = u.pm * BM + wr * 64 + fr, col0 = u.pn * BM + wc * 32 + 4 * fq;
#pragma unroll
        for (int ai = 0; ai < 2; ++ai)
#pragma unroll
            for (int m = 0; m < 4; ++m) { float* rowp = C + (size_t)(row0 + ai * HALF + m * 16) * ldc + col0;
#pragma unroll
                for (int bj = 0; bj < 2; ++bj)
#pragma unroll
                    for (int n = 0; n < 2; ++n) *(f32x4*)(rowp + bj * HALF + n * 16) = acc[ai][bj][m][n]; }
    }
};
template <int ACT  > struct EpiBf16 {
    static constexpr bool PERM = true, AFTER_DRAIN = false;
    bf16_t* O; int ldc;
    __device__ __forceinline__ void operator()(const f32x4 (&acc)[2][2][4][2], const Unit& u, int wr, int wc, int fr, int fq) const {
        const int row0 = u.pm * BM + wr * 64 + fr; const int col0 = u.pn * BM + wc * 32 + 8 * fq;
#pragma unroll
        for (int ai = 0; ai < 2; ++ai)
#pragma unroll
            for (int m = 0; m < 4; ++m) { bf16_t* rowp = O + (size_t)(row0 + ai * HALF + m * 16) * ldc + col0;
#pragma unroll
                for (int bj = 0; bj < 2; ++bj) { f32x4 v0 = acc[ai][bj][m][0], v1 = acc[ai][bj][m][1];
                    if (ACT == 2) {
#pragma unroll
                        for (int j = 0; j < 4; ++j) { const float a = fmaxf(v0[j], 0.f), b = fmaxf(v1[j], 0.f); v0[j] = a * a; v1[j] = b * b; } }
                    u32x4 w; w.x = cvt_pk_bf16(v0[0], v0[1]); w.y = cvt_pk_bf16(v0[2], v0[3]); w.z = cvt_pk_bf16(v1[0], v1[1]); w.w = cvt_pk_bf16(v1[2], v1[3]);
                    *(u32x4*)(rowp + bj * HALF) = w; } }
    }
};

template <class Epi, class Sched, bool ALIGN_EPI = false, bool SP2 = false>
__device__ __forceinline__ void gemm_phase(PG8_LAS unsigned char* lds, const Gemm g, const Sched& S, const Epi& E) {
    int tid_ = threadIdx.x; asm volatile("" : "+v"(tid_)); const int tid = tid_, wid = __builtin_amdgcn_readfirstlane(tid >> 6), lane = tid & 63, wr = wid >> 2, wc = wid & 3, fr = lane & 15, fq = lane >> 4;
    const int K = g.K, nt = K / BK;
    unsigned voffA[2], voffB[2];
#pragma unroll
    for (int i = 0; i < 2; ++i) { int R, C; stage_rc(tid * 16 + i * 8192, R, C); const int Rb = Epi::PERM ? ((R & ~31) + perm32(R & 31)) : R;
        voffA[i] = (unsigned)(R * K + C) * 2u; voffB[i] = (unsigned)(Rb * K + C) * 2u; }
    const size_t kstep = (size_t)(BK * 2);
    const size_t hstep = (size_t)HALF * K * 2;
    const size_t tstep = 2 * hstep;
    const unsigned ldsw = (unsigned)wid * 1024u;
    const int aoff = lds_byte(wr * 64 + fr, fq * 8), boff = lds_byte(wc * 32 + fr, fq * 8);
#define PG8_SA(b, h) (((b) * 2 + (h)) * HTB)
#define PG8_SB(b, h) ((4 + (b) * 2 + (h)) * HTB)
#define PG8_STAGE(bufoff, gbase, voff) do { _Pragma("unroll") for (int _i = 0; _i < 2; ++_i) \
        __builtin_amdgcn_global_load_lds((const unsigned*)((const char*)(gbase) + (voff)[_i]), (PG8_LAS unsigned*)(lds + (bufoff) + ldsw + _i * 8192), 16, 0, 0); } while (0)
#define PG8_LDA(dst, b, h) do { _Pragma("unroll") for (int m = 0; m < 4; ++m) _Pragma("unroll") for (int k = 0; k < 2; ++k) dst[m][k] = *(const PG8_LAS bf16x8*)(lds + PG8_SA(b, h) + aoff + m * 2048 + k * 1024); } while (0)
#define PG8_LDB(dst, b, h) do { _Pragma("unroll") for (int n = 0; n < 2; ++n) _Pragma("unroll") for (int k = 0; k < 2; ++k) dst[n][k] = *(const PG8_LAS bf16x8*)(lds + PG8_SB(b, h) + boff + n * 2048 + k * 1024); } while (0)
#define PG8_MMA(ai, bj, At, Bt) do { __builtin_amdgcn_s_setprio(1); _Pragma("unroll") for (int m = 0; m < 4; ++m) _Pragma("unroll") for (int n = 0; n < 2; ++n) _Pragma("unroll") for (int k = 0; k < 2; ++k) \
        acc[ai][bj][m][n] = __builtin_amdgcn_mfma_f32_16x16x32_bf16(Bt[n][k], At[m][k], acc[ai][bj][m][n], 0, 0, 0); __builtin_amdgcn_s_setprio(0); } while (0)
#define PG8_WAIT_V(n) asm volatile("s_waitcnt vmcnt(" #n ")" ::: "memory")
#define PG8_WAIT_L(n) asm volatile("s_waitcnt lgkmcnt(" #n ")" ::: "memory")
#define PG8_BAR __builtin_amdgcn_s_barrier()
#define PG8_SCHED __builtin_amdgcn_sched_barrier(0)
    Unit cur, nxt; int ui = 0;
    if (!S.next(0, cur)) return;
    f32x4 acc[2][2][4][2];
#pragma unroll
    for (int a = 0; a < 2; ++a)
#pragma unroll
        for (int b = 0; b < 2; ++b)
#pragma unroll
            for (int m = 0; m < 4; ++m)
#pragma unroll
                for (int n = 0; n < 2; ++n) acc[a][b][m][n] = (f32x4){0.f, 0.f, 0.f, 0.f};
    bf16x8 At[4][2], B0[2][2], B1[2][2];
    const char* cA = (const char*)g.A + (size_t)cur.pm * tstep; const char* cB = (const char*)g.Bt + (size_t)cur.pn * tstep;
    S.a_ready(cur);
    if constexpr (SP2) {
        PG8_STAGE(PG8_SB(0, 0), cB, voffB); PG8_STAGE(PG8_SB(0, 1), cB + hstep, voffB); PG8_STAGE(PG8_SA(0, 0), cA, voffA); PG8_STAGE(PG8_SA(0, 1), cA + hstep, voffA);
        if (wr == 1) PG8_BAR;
        PG8_WAIT_V(2); PG8_BAR;
        PG8_STAGE(PG8_SB(1, 0), cB + kstep, voffB); PG8_STAGE(PG8_SA(1, 0), cA + kstep, voffA); PG8_STAGE(PG8_SB(1, 1), cB + hstep + kstep, voffB);
        PG8_WAIT_V(6); PG8_BAR;
    } else {
        PG8_STAGE(PG8_SB(0, 0), cB, voffB); PG8_STAGE(PG8_SA(0, 0), cA, voffA); PG8_STAGE(PG8_SB(0, 1), cB + hstep, voffB); PG8_STAGE(PG8_SA(0, 1), cA + hstep, voffA);
        if (wr == 1) PG8_BAR;
        PG8_WAIT_V(4); PG8_BAR;
        PG8_STAGE(PG8_SB(1, 0), cB + kstep, voffB); PG8_STAGE(PG8_SA(1, 0), cA + kstep, voffA); PG8_STAGE(PG8_SB(1, 1), cB + hstep + kstep, voffB);
        PG8_WAIT_V(6); PG8_BAR;
    }
    for (;;) {
        const bool has_next = S.next(ui + 1, nxt);
        const char* nA = has_next ? (const char*)g.A + (size_t)nxt.pm * tstep : cA; const char* nB = has_next ? (const char*)g.Bt + (size_t)nxt.pn * tstep : cB;
        for (int t = 0; t < nt; t += 2) {
            const bool last = (t == nt - 2);
            const char* a1 = cA + (size_t)(t + 1) * kstep;
            const char* a2 = last ? nA : cA + (size_t)(t + 2) * kstep; const char* b2 = last ? nB : cB + (size_t)(t + 2) * kstep;
            const char* a3 = a2 + kstep; const char* b3 = b2 + kstep;
            if (last && has_next) S.a_ready(nxt);
            if constexpr (SP2) {
            PG8_LDB(B0, 0, 0); PG8_LDB(B1, 0, 1); PG8_SCHED; PG8_LDA(At, 0, 0); PG8_STAGE(PG8_SA(1, 1), a1 + hstep, voffA);
            PG8_WAIT_V(8); PG8_WAIT_L(0); PG8_BAR; PG8_MMA(0, 0, At, B0); PG8_MMA(0, 1, At, B1); PG8_BAR; PG8_SCHED;
            PG8_LDA(At, 0, 1); PG8_STAGE(PG8_SB(0, 0), b2, voffB); PG8_STAGE(PG8_SB(0, 1), b2 + hstep, voffB); PG8_STAGE(PG8_SA(0, 0), a2, voffA);
            PG8_WAIT_V(8); PG8_WAIT_L(0); PG8_BAR; PG8_MMA(1, 0, At, B0); PG8_MMA(1, 1, At, B1); PG8_BAR; PG8_SCHED;
            PG8_LDB(B0, 1, 0); PG8_LDB(B1, 1, 1); PG8_SCHED; PG8_LDA(At, 1, 0); PG8_STAGE(PG8_SA(0, 1), a2 + hstep, voffA);
            PG8_WAIT_V(8); PG8_WAIT_L(0); PG8_BAR; PG8_MMA(0, 0, At, B0); PG8_MMA(0, 1, At, B1); PG8_BAR; PG8_SCHED;
            PG8_LDA(At, 1, 1); PG8_STAGE(PG8_SB(1, 0), b3, voffB); PG8_STAGE(PG8_SB(1, 1), b3 + hstep, voffB); PG8_STAGE(PG8_SA(1, 0), a3, voffA);
            PG8_WAIT_V(8); PG8_WAIT_L(0); PG8_BAR; PG8_MMA(1, 0, At, B0); PG8_MMA(1, 1, At, B1); PG8_BAR; PG8_SCHED;
            } else {
            PG8_LDB(B0, 0, 0); PG8_SCHED; PG8_LDA(At, 0, 0); PG8_STAGE(PG8_SA(1, 1), a1 + hstep, voffA);
            PG8_WAIT_L(8); PG8_BAR; PG8_WAIT_L(0); PG8_MMA(0, 0, At, B0); PG8_BAR; PG8_SCHED;
            PG8_LDB(B1, 0, 1); PG8_STAGE(PG8_SB(0, 0), b2, voffB);
            PG8_BAR; PG8_WAIT_L(0); PG8_MMA(0, 1, At, B1); PG8_BAR;
            PG8_LDA(At, 0, 1); PG8_STAGE(PG8_SA(0, 0), a2, voffA);
            PG8_BAR; PG8_WAIT_L(0); PG8_MMA(1, 0, At, B0); PG8_BAR; PG8_SCHED;
            PG8_STAGE(PG8_SB(0, 1), b2 + hstep, voffB);
            PG8_WAIT_V(6); PG8_BAR; PG8_MMA(1, 1, At, B1); PG8_BAR;
            PG8_LDB(B0, 1, 0); PG8_SCHED; PG8_LDA(At, 1, 0); PG8_STAGE(PG8_SA(0, 1), a2 + hstep, voffA);
            PG8_WAIT_L(8); PG8_BAR; PG8_WAIT_L(0); PG8_MMA(0, 0, At, B0); PG8_BAR; PG8_SCHED;
            PG8_LDB(B1, 1, 1); PG8_STAGE(PG8_SB(1, 0), b3, voffB);
            PG8_BAR; PG8_WAIT_L(0); PG8_MMA(0, 1, At, B1); PG8_BAR;
            PG8_LDA(At, 1, 1); PG8_STAGE(PG8_SA(1, 0), a3, voffA);
            PG8_BAR; PG8_WAIT_L(0); PG8_MMA(1, 0, At, B0); PG8_BAR; PG8_SCHED;
            PG8_STAGE(PG8_SB(1, 1), b3 + hstep, voffB);
            PG8_WAIT_V(6); PG8_BAR; PG8_MMA(1, 1, At, B1); PG8_BAR;
            }
        }
        if constexpr (ALIGN_EPI) { if (wr == 0) PG8_BAR; }
        if constexpr (!Epi::AFTER_DRAIN) { E(acc, cur, wr, wc, fr, fq); S.done(cur); }
        if (!has_next) break;
#pragma unroll
        for (int a = 0; a < 2; ++a)
#pragma unroll
            for (int b = 0; b < 2; ++b)
#pragma unroll
                for (int m = 0; m < 4; ++m)
#pragma unroll
                    for (int n = 0; n < 2; ++n) acc[a][b][m][n] = (f32x4){0.f, 0.f, 0.f, 0.f};
        cur = nxt; cA = nA; cB = nB; ++ui;
        if constexpr (ALIGN_EPI) { if (wr == 1) PG8_BAR; }
    }
    PG8_WAIT_V(0);
    if constexpr (!ALIGN_EPI) { if (wr == 0) PG8_BAR; }
    PG8_BAR;
    if constexpr (Epi::AFTER_DRAIN) { E.fused(acc, cur, wr, wc, fr, fq, lds, wid, lane); S.done(cur); }
#undef PG8_SA
#undef PG8_SB
#undef PG8_STAGE
#undef PG8_LDA
#undef PG8_LDB
#undef PG8_MMA
#undef PG8_WAIT_V
#undef PG8_WAIT_L
#undef PG8_BAR
#undef PG8_SCHED
}
}

constexpr int DM = 2048, NCTX = 4096, NLAT = 8192, MTOK = 12288, DEPTH = 4, DIN = 4608, DFF = 8192, NMODW = 12288;
constexpr int CTX_B = 16, CTX_T = 256, LAT_B = 8, LAT_T = 1024, PAST = 256;
constexpr int C_NAQ = 0, C_NAK = 512, C_NAV = 1024, C_GQ = 1536, C_GK = 2560, C_GV = 2816, C_DQ = 3072, C_DK = 3584, C_DV = 4096;
constexpr int AO_NA = 0, AO_G = 512, AO_D = 1536;
constexpr float EPS = 1e-6f;
constexpr size_t OUT_X = 0, OUT_NAK = 25165824, OUT_NAV = OUT_NAK + 8388608, OUT_GK = OUT_NAV + 8388608, OUT_GV = OUT_GK + 4194304, OUT_DK = OUT_GV + 4194304, OUT_DV = OUT_DK + 8388608, OUT_END = OUT_DV + 8388608;
static_assert(OUT_END == 67108864, "out map");
constexpr size_t MiB = 1u << 20;
constexpr size_t WS_CTL = 0, CTL_ZERO_BYTES = 1 * MiB;
constexpr size_t WS_MOD = 1 * MiB;
constexpr size_t WS_ROPE = 3 * MiB;
constexpr size_t WS_WIN = 4 * MiB;
constexpr size_t WS_WOUT = 76 * MiB;
constexpr size_t WS_WUP = 108 * MiB;
constexpr size_t WS_WDN = 236 * MiB;
constexpr size_t WS_H = 364 * MiB;
constexpr size_t WS_QKV = 412 * MiB;
constexpr size_t WS_AO = 520 * MiB;
constexpr size_t WS_O2 = 568 * MiB;
constexpr size_t WS_U = 664 * MiB;
constexpr size_t WS_CNAK = 856 * MiB, WS_CNAV = 864 * MiB, WS_CGK = 872 * MiB, WS_CGV = 876 * MiB, WS_CDK = 880 * MiB, WS_CDV = 888 * MiB;
constexpr size_t WS_END = 896 * MiB;
constexpr int CW_BAR = 4096;

constexpr int RING_OFF = 0, RING_BYTES = 131072;
constexpr int LDSCTL_OFF = RING_BYTES, MISC_OFF = LDSCTL_OFF + 320;
constexpr int LDS_BYTES = 147456;
constexpr int NWAVES = 8, NTHREADS = 512;

#define GAS __attribute__((address_space(1)))
#define LAS __attribute__((address_space(3)))
typedef unsigned short bf16;
typedef unsigned v4u __attribute__((ext_vector_type(4)));
typedef unsigned v2u __attribute__((ext_vector_type(2)));
typedef float f32x4 __attribute__((ext_vector_type(4)));
typedef float f32x2 __attribute__((ext_vector_type(2)));
#define LDS_WAIT() asm volatile("s_waitcnt lgkmcnt(0)" ::: "memory")
#define VM_WAIT() asm volatile("s_waitcnt vmcnt(0)" ::: "memory")
__device__ __forceinline__ unsigned f2bf(float f) { unsigned u = __builtin_bit_cast(unsigned, f); return (u + 0x7fffu + ((u >> 16) & 1u)) >> 16; }
__device__ __forceinline__ unsigned pk2(float lo, float hi) { return f2bf(lo) | (f2bf(hi) << 16); }
__device__ __forceinline__ float bf_lo(unsigned u) { return __builtin_bit_cast(float, u << 16); }
__device__ __forceinline__ float bf_hi(unsigned u) { return __builtin_bit_cast(float, u & 0xffff0000u); }
__device__ __forceinline__ float wave_sum(float v) {
#pragma unroll
    for (int o = 1; o < 64; o <<= 1) v += __shfl_xor(v, o);
    return v;
}
__device__ __forceinline__ float half_sum(float v) {
#pragma unroll
    for (int o = 1; o < 32; o <<= 1) v += __shfl_xor(v, o);
    return v;
}

struct Args { const float* in[22]; float* out; unsigned char* ws; int ph_lo, ph_hi; };
typedef const __attribute__((address_space(4))) Args CArgs;
__device__ __forceinline__ CArgs* args_here() { CArgs* p = (CArgs*)__builtin_amdgcn_kernarg_segment_ptr(); asm volatile("" : "+s"(p)); return p; }
enum { I_XP = 0, I_XS, I_C, I_CNAK, I_CNAV, I_CGK, I_CGV, I_CDK, I_CDV, I_CCTX, I_WADA, I_BADA, I_NORMG, I_WIN, I_WOUT, I_RPB, I_QG, I_KG, I_LAM, I_DG, I_WUP, I_WDN };

#define XB_TMO      128
#define XB_XCNT(j)  (256  + 64 * (j))
#define XB_XSUB(j)  (1280 + 64 * (j))
#define XB_XGEN(j)  (2304 + 64 * (j))
#define XB_TOP      3328
#define XB_TOPGEN   3392
#define XCD_BAR_WORDS 3456
#define XB_SPIN_CAP (1u << 18)

__device__ __forceinline__ unsigned xb_ld(unsigned* p)              { return __hip_atomic_load(p, __ATOMIC_RELAXED, __HIP_MEMORY_SCOPE_AGENT); }
__device__ __forceinline__ unsigned xb_add(unsigned* p, unsigned v) { return __hip_atomic_fetch_add(p, v, __ATOMIC_RELAXED, __HIP_MEMORY_SCOPE_AGENT); }
__device__ __forceinline__ unsigned xb_xcc_id() { return (unsigned)__builtin_amdgcn_s_getreg((3 << 11) | 20) & 0xFu; }
#define XB_SPIN(cond, bar) do { unsigned _sp = 0; while (cond) { __builtin_amdgcn_s_sleep(1); \
    if ((++_sp & 255u) == 0u) { if (xb_ld(&(bar)[XB_TMO])) break; if (_sp > XB_SPIN_CAP) { atomicAdd(&(bar)[XB_TMO], 1u); break; } } } } while (0)

struct XcdBarrier {
    unsigned* bar; unsigned x;
    volatile LAS unsigned* st;
};

__device__ __forceinline__ XcdBarrier xcd_barrier_post(unsigned* bar, volatile LAS unsigned* st) {
    XcdBarrier b; b.bar = bar; b.x = xb_xcc_id(); b.st = st;
    if (threadIdx.x == 0) (void)xb_add(&bar[XB_XCNT(b.x)], 1u);
    return b;
}
__device__ __forceinline__ void xcd_barrier_complete(unsigned* bar, unsigned x, unsigned& nloc, unsigned& nx) {
    const unsigned G = gridDim.x * gridDim.y * gridDim.z;
    unsigned sum, cnt, mine, sp = 0u;
    for (;;) {
        sum = 0u; cnt = 0u; mine = 0u;
#pragma unroll
        for (unsigned j = 0; j < 16; ++j) { const unsigned c = xb_ld(&bar[XB_XCNT(j)]); sum += c; cnt += (c > 0u) ? 1u : 0u; mine = (j == x) ? c : mine; }
        if (sum == G) break;
        __builtin_amdgcn_s_sleep(1);
        if ((++sp & 255u) == 0u) { if (xb_ld(&bar[XB_TMO])) break; if (sp > XB_SPIN_CAP) { atomicAdd(&bar[XB_TMO], 1u); break; } }
    }
    nloc = mine > 0u ? mine : 1u; nx = cnt > 0u ? cnt : 1u;
}

__device__ __forceinline__ void xcd_barrier(const XcdBarrier& b) {
    asm volatile("s_waitcnt vmcnt(0)" ::: "memory");
    __syncthreads();
    if (threadIdx.x == 0) {
        unsigned* bar = b.bar;
        __builtin_amdgcn_s_waitcnt(0);
        unsigned nloc = b.st[0], nx = b.st[1];
        if (nloc == 0u) { xcd_barrier_complete(bar, b.x, nloc, nx); b.st[0] = nloc; b.st[1] = nx; }
        const unsigned old = xb_add(&bar[XB_XSUB(b.x)], 1u);
        const unsigned gen = old / nloc;
        if (old + 1u == (gen + 1u) * nloc) {
            __builtin_amdgcn_fence(__ATOMIC_RELEASE, "agent");
            asm volatile("s_waitcnt vmcnt(0)" ::: "memory");
            const unsigned og = xb_add(&bar[XB_TOP], 1u);
            const unsigned tg = og / nx;
            if (og + 1u == (tg + 1u) * nx) xb_add(&bar[XB_TOPGEN], 1u);
            else XB_SPIN(xb_ld(&bar[XB_TOPGEN]) == tg, bar);
            __builtin_amdgcn_fence(__ATOMIC_ACQUIRE, "agent");
            xb_add(&bar[XB_XGEN(b.x)], 1u);
            asm volatile("s_waitcnt vmcnt(0)" ::: "memory");
        } else {
            XB_SPIN(xb_ld(&bar[XB_XGEN(b.x)]) == gen, bar);
            __builtin_amdgcn_fence(__ATOMIC_ACQUIRE, "agent");
            asm volatile("s_waitcnt vmcnt(0)" ::: "memory");
        }
    }
    __syncthreads();
}
struct Ctx { LAS unsigned char* lds; int tid, lane, wave, vcu, G, gw, NGW; };

__device__ __forceinline__ void p0_transpose_item(const float* W, int K, int N, bf16* WT, LAS float* scr, int item, int lane) {
    const int nblk = N / 32, kb = item / nblk, nb = item % nblk, k0 = 64 * kb, n0 = 32 * nb;
#pragma unroll 8
    for (int i = 0; i < 32; ++i) { const int kk = 2 * i + (lane >> 5); scr[kk * 33 + (lane & 31)] = W[(size_t)(k0 + kk) * N + n0 + (lane & 31)]; }
    LDS_WAIT(); asm volatile("" ::: "memory");
    const int c = lane & 7;
#pragma unroll
    for (int j = 0; j < 4; ++j) { const int n = (lane >> 3) + 8 * j; const LAS float* s = scr + (8 * c) * 33 + n;
        v4u o; o.x = pk2(s[0 * 33], s[1 * 33]); o.y = pk2(s[2 * 33], s[3 * 33]); o.z = pk2(s[4 * 33], s[5 * 33]); o.w = pk2(s[6 * 33], s[7 * 33]);
        *(GAS v4u*)(WT + (size_t)(n0 + n) * K + k0 + 8 * c) = o; }
    LDS_WAIT(); asm volatile("" ::: "memory");
}

__device__ __forceinline__ void cvt_tensor(const float* src, bf16* dst, size_t n8, size_t gt, size_t NT) {
    for (size_t i = gt; i < n8; i += NT) { const f32x4 a = *(const f32x4*)(src + i * 8), b = *(const f32x4*)(src + i * 8 + 4);
        v4u o; o.x = pk2(a.x, a.y); o.y = pk2(a.z, a.w); o.z = pk2(b.x, b.y); o.w = pk2(b.z, b.w); *(v4u*)(dst + i * 8) = o; }
}

__device__ __forceinline__ void ph_prologue(CArgs* a, const Ctx& X) {
    unsigned char* ws = a->ws;
#ifndef PROMASK
#define PROMASK 15
#endif
    if (PROMASK & 1)
    {
        constexpr int SLW = 2176;
        LAS float* sl = (LAS float*)X.lds; LAS float* red = (LAS float*)(X.lds + 9 * SLW * 4);
        const float* cin = a->in[I_C]; const float* cctx = a->in[I_CCTX];
        for (int i = X.tid; i < 9 * 2048; i += NTHREADS) { const int v = i >> 11, k = i & 2047; const float x = (v < 8) ? cin[v * 2048 + k] : cctx[k];
            sl[v * SLW + k + 4 * (k >> 6)] = x / (1.0f + expf(-x)); }
        __syncthreads();
        float* mod = (float*)(ws + WS_MOD); const float* wada = a->in[I_WADA]; const float* bada = a->in[I_BADA];
        const int kq = X.tid >> 4, cg = X.tid & 15, k0 = kq * 64;
        for (int item = X.vcu; item < DEPTH * 192; item += X.G) {
            const int l = item / 192, n0 = (item % 192) * 64;
            const float* W = wada + (size_t)l * DM * NMODW + n0 + 4 * cg;
            f32x4 acc[9];
#pragma unroll
            for (int v = 0; v < 9; ++v) acc[v] = (f32x4){0.f, 0.f, 0.f, 0.f};
#pragma unroll 1
            for (int kk = 0; kk < 64; kk += 4) {
                const f32x4 w0 = *(const f32x4*)(W + (size_t)(k0 + kk) * NMODW), w1 = *(const f32x4*)(W + (size_t)(k0 + kk + 1) * NMODW),
                            w2 = *(const f32x4*)(W + (size_t)(k0 + kk + 2) * NMODW), w3 = *(const f32x4*)(W + (size_t)(k0 + kk + 3) * NMODW);
#pragma unroll
                for (int v = 0; v < 9; ++v) { const f32x4 s = *(const LAS f32x4*)(sl + v * SLW + k0 + kk + 4 * kq);
                    acc[v] += w0 * s.x + w1 * s.y + w2 * s.z + w3 * s.w; }
            }
#pragma unroll
            for (int v = 0; v < 9; ++v)
#pragma unroll
                for (int j = 0; j < 4; ++j) { float t = acc[v][j]; t += __shfl_xor(t, 16); t += __shfl_xor(t, 32); acc[v][j] = t; }
            if (X.lane < 16) {
#pragma unroll
                for (int v = 0; v < 9; ++v) *(LAS f32x4*)(red + (X.wave * 9 + v) * 64 + 4 * X.lane) = acc[v];
            }
            __syncthreads();
            for (int o = X.tid; o < 576; o += NTHREADS) { const int v = o >> 6, cc = o & 63; float s = 0.f;
#pragma unroll
                for (int w = 0; w < 8; ++w) s += red[(w * 9 + v) * 64 + cc];
                mod[(size_t)(l * 9 + v) * NMODW + n0 + cc] = s + bada[l * NMODW + n0 + cc]; }
            __syncthreads();
        }
    }
    if (PROMASK & 2)
    {
        LAS float* scr = (LAS float*)(X.lds + RING_OFF + X.wave * 16384);
        constexpr int I_IN = (DM / 64) * (DIN / 32), I_OUT = (DM / 64) * (DM / 32), I_UP = (DM / 64) * (DFF / 32), I_DN = (DFF / 64) * (DM / 32);
        constexpr int PER_L = I_IN + I_OUT + I_UP + I_DN;
        for (int it = X.gw; it < DEPTH * PER_L; it += X.NGW) {
            const int l = it / PER_L; int r = it % PER_L;
            if (r < I_IN) { p0_transpose_item(a->in[I_WIN] + (size_t)l * DM * DIN, DM, DIN, (bf16*)(ws + WS_WIN) + (size_t)l * DIN * DM, scr, r, X.lane); continue; } r -= I_IN;
            if (r < I_OUT) { p0_transpose_item(a->in[I_WOUT] + (size_t)l * DM * DM, DM, DM, (bf16*)(ws + WS_WOUT) + (size_t)l * DM * DM, scr, r, X.lane); continue; } r -= I_OUT;
            if (r < I_UP) { p0_transpose_item(a->in[I_WUP] + (size_t)l * DM * DFF, DM, DFF, (bf16*)(ws + WS_WUP) + (size_t)l * DFF * DM, scr, r, X.lane); continue; } r -= I_UP;
            p0_transpose_item(a->in[I_WDN] + (size_t)l * DFF * DM, DFF, DM, (bf16*)(ws + WS_WDN) + (size_t)l * DM * DFF, scr, r, X.lane);
        }
    }
    if (PROMASK & 4)
    {
        f32x2* rope = (f32x2*)(ws + WS_ROPE);
        for (int i = X.vcu * NTHREADS + X.tid; i < 64 * 48; i += X.G * NTHREADS) { const int pos = i / 48, f = i % 48;
            const double e = (f < 32) ? (double)f / 32.0 : (double)(f - 32) / 16.0;
            const float inv = (float)exp(-9.210340371976184 * e); const float ang = (float)pos * inv;
            const double ad = (double)ang; const double nq = __builtin_rint(ad * 0.6366197723675814); const double r = ad - nq * 1.5707963267948966, r2 = r * r;
            const double sr = r * (1.0 + r2 * (-1.0 / 6 + r2 * (1.0 / 120 + r2 * (-1.0 / 5040 + r2 * (1.0 / 362880 + r2 * (-1.0 / 39916800 + r2 * (1.0 / 6227020800.0)))))));
            const double cr = 1.0 + r2 * (-0.5 + r2 * (1.0 / 24 + r2 * (-1.0 / 720 + r2 * (1.0 / 40320 + r2 * (-1.0 / 3628800 + r2 * (1.0 / 479001600 + r2 * (-1.0 / 87178291200.0)))))));
            const int q = ((int)nq) & 3;
            const double cv = (q == 0) ? cr : (q == 1) ? -sr : (q == 2) ? -cr : sr, sv = (q == 0) ? sr : (q == 1) ? cr : (q == 2) ? -sr : -cr;
            rope[i] = (f32x2){(float)cv, (float)sv}; }
    }
    if (PROMASK & 8)
    {
        const size_t gt = (size_t)X.vcu * NTHREADS + X.tid, NT = (size_t)X.G * NTHREADS;
        cvt_tensor(a->in[I_CNAK], (bf16*)(ws + WS_CNAK), (size_t)LAT_B * DEPTH * PAST * 512 / 8, gt, NT);
        cvt_tensor(a->in[I_CNAV], (bf16*)(ws + WS_CNAV), (size_t)LAT_B * DEPTH * PAST * 512 / 8, gt, NT);
        cvt_tensor(a->in[I_CGK], (bf16*)(ws + WS_CGK), (size_t)LAT_B * DEPTH * PAST * 256 / 8, gt, NT);
        cvt_tensor(a->in[I_CGV], (bf16*)(ws + WS_CGV), (size_t)LAT_B * DEPTH * PAST * 256 / 8, gt, NT);
        cvt_tensor(a->in[I_CDK], (bf16*)(ws + WS_CDK), (size_t)LAT_B * DEPTH * PAST * 512 / 8, gt, NT);
        cvt_tensor(a->in[I_CDV], (bf16*)(ws + WS_CDV), (size_t)LAT_B * DEPTH * PAST * 512 / 8, gt, NT);
    }
}

__device__ __forceinline__ int mod_vec(int m) { return m < NCTX ? 8 : ((m - NCTX) >> 10); }

template <bool UPD, bool FIRST>
__device__ __forceinline__ void norm_rows(CArgs* a, const Ctx& X, const float* o2, const float* g_post, const float* mod_gate, int gate_off,
                                          const float* g_pre, const float* mod_next, int sh_off, int sc_off, bool write_h) {
    float* xbuf = a->out; bf16* H = (bf16*)(a->ws + WS_H);
    for (int m = X.gw; m < MTOK; m += X.NGW) {
        const int mv = mod_vec(m);
        f32x4 x[8];
        if (FIRST) { const float* src = (m < NCTX) ? a->in[I_XP] + (size_t)m * DM : a->in[I_XS] + (size_t)(m - NCTX) * DM;
#pragma unroll
            for (int j = 0; j < 8; ++j) x[j] = *(const f32x4*)(src + 4 * X.lane + 256 * j);
        } else {
#pragma unroll
            for (int j = 0; j < 8; ++j) x[j] = *(const f32x4*)(xbuf + (size_t)m * DM + 4 * X.lane + 256 * j);
        }
        if (UPD) {
            f32x4 o[8]; float ss = 0.f;
#pragma unroll
            for (int j = 0; j < 8; ++j) { o[j] = *(const f32x4*)(o2 + (size_t)m * DM + 4 * X.lane + 256 * j); ss += (o[j].x * o[j].x + o[j].y * o[j].y) + (o[j].z * o[j].z + o[j].w * o[j].w); }
            const float r1 = 1.0f / sqrtf(wave_sum(ss) * (1.0f / DM) + EPS);
#pragma unroll
            for (int j = 0; j < 8; ++j) { const int col = 4 * X.lane + 256 * j;
                const f32x4 gp = *(const f32x4*)(g_post + col), gt = *(const f32x4*)(mod_gate + (size_t)mv * NMODW + gate_off + col);
                x[j] = x[j] + gt * ((o[j] * r1) * gp); }
        }
        if (UPD || FIRST) {
#pragma unroll
            for (int j = 0; j < 8; ++j) *(f32x4*)(xbuf + (size_t)m * DM + 4 * X.lane + 256 * j) = x[j];
        }
        if (write_h) {
            float ss = 0.f;
#pragma unroll
            for (int j = 0; j < 8; ++j) ss += (x[j].x * x[j].x + x[j].y * x[j].y) + (x[j].z * x[j].z + x[j].w * x[j].w);
            const float r2 = 1.0f / sqrtf(wave_sum(ss) * (1.0f / DM) + EPS);
#pragma unroll
            for (int j = 0; j < 8; ++j) { const int col = 4 * X.lane + 256 * j;
                const f32x4 g = *(const f32x4*)(g_pre + col), sc = *(const f32x4*)(mod_next + (size_t)mv * NMODW + sc_off + col), sh = *(const f32x4*)(mod_next + (size_t)mv * NMODW + sh_off + col);
                const f32x4 h = ((x[j] * r2) * g) * (sc + 1.0f) + sh;
                v2u w; w.x = pk2(h.x, h.y); w.y = pk2(h.z, h.w); *(v2u*)(H + (size_t)m * DM + col) = w; }
        }
    }
}

__device__ __forceinline__ void ph_fixup(CArgs* a, const Ctx& X, int l) {
    bf16* QKV = (bf16*)(a->ws + WS_QKV); const f32x2* rope = (const f32x2*)(a->ws + WS_ROPE);
    const int lane = X.lane;
    const float qg0 = a->in[I_QG][l * 128 + 2 * lane], qg1 = a->in[I_QG][l * 128 + 2 * lane + 1];
    const float kg0 = a->in[I_KG][l * 128 + 2 * lane], kg1 = a->in[I_KG][l * 128 + 2 * lane + 1];
    for (int m = X.gw; m < MTOK; m += X.NGW) {
        bf16* row = QKV + (size_t)m * DIN;
        const bool lat = m >= NCTX; const int t = (m - NCTX) & 1023, prow = t >> 6, pcol = t & 63;
        const int cb = m >> 8, ct = m & 255;
        for (int hh = 0; hh < 10; ++hh) {
            const int col = hh < 8 ? C_GQ + hh * 128 : C_GK + (hh - 8) * 128;
            const unsigned u = *(const unsigned*)(row + col + 2 * lane); float x0 = bf_lo(u), x1 = bf_hi(u);
            const float r = 1.0f / sqrtf(wave_sum(x0 * x0 + x1 * x1) * (1.0f / 128.0f) + EPS);
            x0 = x0 * r * (hh < 8 ? qg0 : kg0); x1 = x1 * r * (hh < 8 ? qg1 : kg1);
            if (lat) {
                const int pos = (lane < 32) ? prow : pcol, fi = (2 * lane) & 31;
                const f32x2 cs0 = rope[pos * 48 + fi], cs1 = rope[pos * 48 + fi + 1];
                const float p0 = __shfl_xor(x0, 16), p1 = __shfl_xor(x1, 16), sg = (lane & 16) ? 1.0f : -1.0f;
                x0 = x0 * cs0.x + sg * p0 * cs0.y; x1 = x1 * cs1.x + sg * p1 * cs1.y;
            }
            *(unsigned*)(row + col + 2 * lane) = pk2(x0, x1);
            if (!lat && hh >= 8) *(f32x2*)(a->out + OUT_GK + ((size_t)(cb * DEPTH + l) * CTX_T + ct) * 256 + (hh - 8) * 128 + 2 * lane) = (f32x2){x0, x1};
        }
        if (lat) {
            for (int hh = 0; hh < 8; ++hh) {
                const int col = hh < 4 ? C_DQ + hh * 128 : C_DK + (hh - 4) * 128;
                const unsigned u = *(const unsigned*)(row + col + 2 * lane); float x0 = bf_lo(u), x1 = bf_hi(u);
                const int pos = (lane & 16) ? pcol : prow, fi = 32 + ((2 * lane) & 15);
                const f32x2 cs0 = rope[pos * 48 + fi], cs1 = rope[pos * 48 + fi + 1];
                const float p0 = __shfl_xor(x0, 8), p1 = __shfl_xor(x1, 8), sg = (lane & 8) ? 1.0f : -1.0f;
                x0 = x0 * cs0.x + sg * p0 * cs0.y; x1 = x1 * cs1.x + sg * p1 * cs1.y;
                *(unsigned*)(row + col + 2 * lane) = pk2(x0, x1);
            }
        } else {
            const size_t r5 = ((size_t)(cb * DEPTH + l) * CTX_T + ct) * 512, r2 = ((size_t)(cb * DEPTH + l) * CTX_T + ct) * 256;
#pragma unroll
            for (int j = 0; j < 4; ++j) {
                unsigned u = *(const unsigned*)(row + C_NAK + j * 128 + 2 * lane); *(f32x2*)(a->out + OUT_NAK + r5 + j * 128 + 2 * lane) = (f32x2){bf_lo(u), bf_hi(u)};
                u = *(const unsigned*)(row + C_NAV + j * 128 + 2 * lane); *(f32x2*)(a->out + OUT_NAV + r5 + j * 128 + 2 * lane) = (f32x2){bf_lo(u), bf_hi(u)};
                u = *(const unsigned*)(row + C_DK + j * 128 + 2 * lane); *(f32x2*)(a->out + OUT_DK + r5 + j * 128 + 2 * lane) = (f32x2){bf_lo(u), bf_hi(u)};
                u = *(const unsigned*)(row + C_DV + j * 128 + 2 * lane); *(f32x2*)(a->out + OUT_DV + r5 + j * 128 + 2 * lane) = (f32x2){bf_lo(u), bf_hi(u)};
            }
#pragma unroll
            for (int j = 0; j < 2; ++j) { const unsigned u = *(const unsigned*)(row + C_GV + j * 128 + 2 * lane); *(f32x2*)(a->out + OUT_GV + r2 + j * 128 + 2 * lane) = (f32x2){bf_lo(u), bf_hi(u)}; }
        }
    }
}

__device__ __forceinline__ float lambda_init_of(int l) { return 0.8f - 0.6f * expf(-0.3f * (float)l); }

struct SmState { float m, l, o0, o1; };
__device__ __forceinline__ void sm_step(SmState& S, float s, float v0, float v1) {
    const float mn = fmaxf(S.m, s), al = __expf(S.m - mn), p = __expf(s - mn);
    S.l = S.l * al + p; S.o0 = S.o0 * al + p * v0; S.o1 = S.o1 * al + p * v1; S.m = mn;
}
__device__ __forceinline__ void ph_attn_naive(CArgs* a, const Ctx& X, int l) {
    const bf16* QKV = (const bf16*)(a->ws + WS_QKV); bf16* AO = (bf16*)(a->ws + WS_AO);
    const int lane = X.lane;
    const float li = lambda_init_of(l);
    const float* lamv = a->in[I_LAM] + l * 256;
    const float lam = expf(wave_sum(lamv[lane] * lamv[64 + lane])) - expf(wave_sum(lamv[128 + lane] * lamv[192 + lane])) + li;
    const float dg0 = a->in[I_DG][l * 128 + 2 * lane], dg1 = a->in[I_DG][l * 128 + 2 * lane + 1];
    for (int item = X.gw; item < MTOK * 16; item += X.NGW) {
        const int m = item >> 4, hu = item & 15; const bool lat = m >= NCTX;
        const bf16* qrow = QKV + (size_t)m * DIN;
        if (hu < 12) {
            int qc, kc, vc, ocol, cw, ch; const bf16 *ck, *cv;
            if (hu < 4) { qc = C_NAQ + hu * 128; kc = C_NAK + hu * 128; vc = C_NAV + hu * 128; ocol = AO_NA + hu * 128; cw = 512; ch = hu; ck = (const bf16*)(a->ws + WS_CNAK); cv = (const bf16*)(a->ws + WS_CNAV); }
            else { const int hq = hu - 4, kvh = hq >> 2; qc = C_GQ + hq * 128; kc = C_GK + kvh * 128; vc = C_GV + kvh * 128; ocol = AO_G + hq * 128; cw = 256; ch = kvh; ck = (const bf16*)(a->ws + WS_CGK); cv = (const bf16*)(a->ws + WS_CGV); }
            const unsigned uq = *(const unsigned*)(qrow + qc + 2 * lane); const float q0 = bf_lo(uq), q1 = bf_hi(uq);
            const float scale = 0.08838834764831845f;
            SmState S{-1e30f, 0.f, 0.f, 0.f};
            if (!lat) { const int b = m >> 8;
                for (int s = 0; s < CTX_T; ++s) { const bf16* kr = QKV + (size_t)(b * CTX_T + s) * DIN;
                    const unsigned uk = *(const unsigned*)(kr + kc + 2 * lane), uv = *(const unsigned*)(kr + vc + 2 * lane);
                    const float sc = wave_sum(q0 * bf_lo(uk) + q1 * bf_hi(uk)) * scale; sm_step(S, sc, bf_lo(uv), bf_hi(uv)); }
            } else { const int b = (m - NCTX) >> 10, t = (m - NCTX) & 1023;
                if (hu < 4) { const int rq = t >> 6, cq = t & 63; const int r0 = min(max(rq - 4, 0), 8), w0 = min(max(cq - 8, 0), 48);
                    const float* rpb = a->in[I_RPB] + (size_t)(l * 4 + hu) * 15 * 31;
                    for (int rk = r0; rk < r0 + 8; ++rk) for (int ckk = w0; ckk < w0 + 16; ++ckk) {
                        const bf16* kr = QKV + (size_t)(NCTX + b * LAT_T + rk * 64 + ckk) * DIN;
                        const unsigned uk = *(const unsigned*)(kr + kc + 2 * lane), uv = *(const unsigned*)(kr + vc + 2 * lane);
                        const float sc = wave_sum(q0 * bf_lo(uk) + q1 * bf_hi(uk)) * scale + rpb[(rk - rq + 7) * 31 + (ckk - cq + 15)]; sm_step(S, sc, bf_lo(uv), bf_hi(uv)); }
                } else {
                    for (int s = 0; s < LAT_T; ++s) { const bf16* kr = QKV + (size_t)(NCTX + b * LAT_T + s) * DIN;
                        const unsigned uk = *(const unsigned*)(kr + kc + 2 * lane), uv = *(const unsigned*)(kr + vc + 2 * lane);
                        const float sc = wave_sum(q0 * bf_lo(uk) + q1 * bf_hi(uk)) * scale; sm_step(S, sc, bf_lo(uv), bf_hi(uv)); }
                }
                for (int s = 0; s < PAST; ++s) { const size_t off = ((size_t)(b * DEPTH + l) * PAST + s) * cw + ch * 128 + 2 * lane;
                    const unsigned uk = *(const unsigned*)(ck + off), uv = *(const unsigned*)(cv + off);
                    const float sc = wave_sum(q0 * bf_lo(uk) + q1 * bf_hi(uk)) * scale; sm_step(S, sc, bf_lo(uv), bf_hi(uv)); }
            }
            const float inv = 1.0f / S.l;
            *(unsigned*)(AO + (size_t)m * DM + ocol + 2 * lane) = pk2(S.o0 * inv, S.o1 * inv);
        } else {
            const int h = hu - 12, qc = C_DQ + h * 128, kc = C_DK + h * 128, vc = C_DV + h * 128;
            const unsigned uq = *(const unsigned*)(qrow + qc + 2 * lane); const float q0 = bf_lo(uq), q1 = bf_hi(uq);
            const float scale = 0.125f;
            float mm = -1e30f, ll = 0.f;
            float a0 = 0.f, a1 = 0.f, b0 = 0.f, b1 = 0.f;
#define DIFF_STEP(uk, uv) do { const float sc = half_sum(q0 * bf_lo(uk) + q1 * bf_hi(uk)) * scale; const float mn = fmaxf(mm, sc), al = __expf(mm - mn), p = __expf(sc - mn); \
            ll = ll * al + p; mm = mn; const float al0 = __shfl(al, 0), al1 = __shfl(al, 32), p0 = __shfl(p, 0), p1 = __shfl(p, 32); const float v0 = bf_lo(uv), v1 = bf_hi(uv); \
            a0 = a0 * al0 + p0 * v0; a1 = a1 * al0 + p0 * v1; b0 = b0 * al1 + p1 * v0; b1 = b1 * al1 + p1 * v1; } while (0)
            if (!lat) { const int b = m >> 8;
                for (int s = 0; s < CTX_T; ++s) { const bf16* kr = QKV + (size_t)(b * CTX_T + s) * DIN;
                    const unsigned uk = *(const unsigned*)(kr + kc + 2 * lane), uv = *(const unsigned*)(kr + vc + 2 * lane); DIFF_STEP(uk, uv); }
            } else { const int b = (m - NCTX) >> 10;
                for (int s = 0; s < LAT_T; ++s) { const bf16* kr = QKV + (size_t)(NCTX + b * LAT_T + s) * DIN;
                    const unsigned uk = *(const unsigned*)(kr + kc + 2 * lane), uv = *(const unsigned*)(kr + vc + 2 * lane); DIFF_STEP(uk, uv); }
                const bf16* ck = (const bf16*)(a->ws + WS_CDK); const bf16* cv = (const bf16*)(a->ws + WS_CDV);
                for (int s = 0; s < PAST; ++s) { const size_t off = ((size_t)(b * DEPTH + l) * PAST + s) * 512 + h * 128 + 2 * lane;
                    const unsigned uk = *(const unsigned*)(ck + off), uv = *(const unsigned*)(cv + off); DIFF_STEP(uk, uv); }
            }
#undef DIFF_STEP
            const float l0 = __shfl(ll, 0), l1 = __shfl(ll, 32);
            float o0 = a0 / l0 - lam * (b0 / l1), o1 = a1 / l0 - lam * (b1 / l1);
            const float r = 1.0f / sqrtf(wave_sum(o0 * o0 + o1 * o1) * (1.0f / 128.0f) + EPS);
            o0 = o0 * r * dg0 * (1.0f - li); o1 = o1 * r * dg1 * (1.0f - li);
            *(unsigned*)(AO + (size_t)m * DM + AO_D + h * 128 + 2 * lane) = pk2(o0, o1);
        }
    }
}

namespace att {
using bf16x8 = __attribute__((ext_vector_type(8))) short;
using s16x4  = __attribute__((ext_vector_type(4))) short;
using f32x16 = __attribute__((ext_vector_type(16))) float;
constexpr int QBLK = 32, KVBLK = 64, NW = 8;
constexpr int SHM_V = KVBLK * 128 * 2, SHM_K = KVBLK * 128 * 2;
constexpr int OFF_WS = 2 * SHM_V + 2 * SHM_K, OFF_BT = OFF_WS + NW * 64 * 4, OFF_Q = OFF_BT + 576 * 4, ATT_LDS = OFF_Q + 64;
constexpr float THR = 8.f;
#define KSWZ(row, colB) ((row) * 256 + ((colB) ^ (((row) & 7) << 4)))
#define SBAR() __builtin_amdgcn_sched_barrier(0)
__device__ __forceinline__ int crow(int r, int hi) { return (r & 3) + 8 * (r >> 2) + 4 * hi; }
__device__ __forceinline__ unsigned cvtpk(float lo, float hi) { unsigned r; asm volatile("v_cvt_pk_bf16_f32 %0, %1, %2" : "=v"(r) : "v"(lo), "v"(hi)); return r; }

template <int KIND> struct Sc { static constexpr float SCALE = (KIND == 2) ? 0.125f : 0.08838834764831845f; };

template <int KIND>
__device__ __forceinline__ void partialSM(f32x16& p0, f32x16& p1, float& m_reg, float& mn, float& alpha) {
  constexpr float SCALE = Sc<KIND>::SCALE, C = SCALE * 1.4426950408889634f;
  float pmax = p0[0];
#pragma unroll
  for (int r = 1; r < 16; ++r) pmax = fmaxf(pmax, p0[r]);
#pragma unroll
  for (int r = 0; r < 16; ++r) pmax = fmaxf(pmax, p1[r]);
  { auto rr = __builtin_amdgcn_permlane32_swap(__float_as_uint(pmax), __float_as_uint(pmax), false, false);
    pmax = fmaxf(__uint_as_float(rr[0]), __uint_as_float(rr[1])); }
  if (__builtin_expect(__all(pmax - m_reg <= THR / SCALE), 1)) { mn = m_reg; alpha = 1.f; }
  else { mn = fmaxf(m_reg, pmax); alpha = __builtin_amdgcn_exp2f((m_reg - mn) * C); m_reg = mn; }
  float mnC = -mn * C;
#pragma unroll
  for (int r = 0; r < 16; ++r) p0[r] = fmaf(p0[r], C, mnC);
#pragma unroll
  for (int r = 0; r < 16; ++r) p1[r] = fmaf(p1[r], C, mnC);
#pragma unroll
  for (int r = 0; r < 16; ++r) p0[r] = __builtin_amdgcn_exp2f(p0[r]);
}
__device__ __forceinline__ void finishSM(f32x16& p0, f32x16& p1, float alpha, float& l_reg, bf16x8& pa0, bf16x8& pa1, bf16x8& pa2, bf16x8& pa3) {
#pragma unroll
  for (int r = 0; r < 16; ++r) p1[r] = __builtin_amdgcn_exp2f(p1[r]);
  float ps = 0;
#pragma unroll
  for (int r = 0; r < 16; ++r) ps += p0[r];
#pragma unroll
  for (int r = 0; r < 16; ++r) ps += p1[r];
  { auto rr = __builtin_amdgcn_permlane32_swap(__float_as_uint(ps), __float_as_uint(ps), false, false);
    ps = __uint_as_float(rr[0]) + __uint_as_float(rr[1]); }
  l_reg = l_reg * alpha + ps;
#define PK4(P, BASE, OUT) do { unsigned a0 = cvtpk(P[BASE + 0], P[BASE + 1]), a1 = cvtpk(P[BASE + 2], P[BASE + 3]);   \
    unsigned b0 = cvtpk(P[BASE + 4], P[BASE + 5]), b1 = cvtpk(P[BASE + 6], P[BASE + 7]);                              \
    auto r0 = __builtin_amdgcn_permlane32_swap(a0, b0, false, false); auto r1 = __builtin_amdgcn_permlane32_swap(a1, b1, false, false); \
    v4u w = {r0[0], r1[0], r0[1], r1[1]}; OUT = __builtin_bit_cast(bf16x8, w); } while (0)
  PK4(p0, 0, pa0); PK4(p0, 8, pa1); PK4(p1, 0, pa2); PK4(p1, 8, pa3);
#undef PK4
}
template <int ND0>
__device__ __forceinline__ void qkt(f32x16& p0, f32x16& p1, const LAS char* Ks, const bf16x8* qr, int r32, int hi, int dbase) {
  p0 = f32x16{}; p1 = f32x16{};
#pragma unroll
  for (int d0 = 0; d0 < ND0; ++d0) { const int cb = (dbase + d0 * 16 + hi * 8) * 2;
    const bf16x8 b0 = *(const LAS bf16x8*)(Ks + KSWZ(r32, cb));
    const bf16x8 b1 = *(const LAS bf16x8*)(Ks + KSWZ(32 + r32, cb));
    p0 = __builtin_amdgcn_mfma_f32_32x32x16_bf16(b0, qr[d0], p0, 0, 0, 0);
    p1 = __builtin_amdgcn_mfma_f32_32x32x16_bf16(b1, qr[d0], p1, 0, 0, 0); }
}
__device__ __forceinline__ int v_st(int k, int c) { const int kk = (k & ~0xC) | ((k & 4) << 1) | ((k & 8) >> 1); return ((kk >> 3) * 4 + (c >> 5)) * 512 + ((kk & 7) * 32 + (c & 31)) * 2; }
__device__ __forceinline__ int v_rd_base(int lane) { return ((lane & 3) << 3) | (((lane >> 2) & 3) << 6) | (((lane >> 4) & 1) << 5) | (((lane >> 5) & 1) << 8); }
constexpr int v_rd_off(int d0, int ks, int half) { return d0 * 512 + ks * 4096 + half * 2048; }
template <int OFF> __device__ __forceinline__ s16x4 tr_read(int vb) {
  s16x4 r; asm volatile("ds_read_b64_tr_b16 %0, %1 offset:%2" : "=&v"(r) : "v"(vb), "i"(OFF) : "memory"); return r;
}
template <int D0> __device__ __forceinline__ void pv_one(f32x16& od, int vb, bf16x8 pa0, bf16x8 pa1, bf16x8 pa2, bf16x8 pa3) {
  const s16x4 l0 = tr_read<v_rd_off(D0, 0, 0)>(vb), h0 = tr_read<v_rd_off(D0, 0, 1)>(vb), l1 = tr_read<v_rd_off(D0, 1, 0)>(vb), h1 = tr_read<v_rd_off(D0, 1, 1)>(vb);
  const s16x4 l2 = tr_read<v_rd_off(D0, 2, 0)>(vb), h2 = tr_read<v_rd_off(D0, 2, 1)>(vb), l3 = tr_read<v_rd_off(D0, 3, 0)>(vb), h3 = tr_read<v_rd_off(D0, 3, 1)>(vb);
  asm volatile("s_waitcnt lgkmcnt(0)" ::: "memory"); SBAR();
#define PK(L, H) (bf16x8){L[0], L[1], L[2], L[3], H[0], H[1], H[2], H[3]}
  od = __builtin_amdgcn_mfma_f32_32x32x16_bf16(pa0, PK(l0, h0), od, 0, 0, 0);
  od = __builtin_amdgcn_mfma_f32_32x32x16_bf16(pa1, PK(l1, h1), od, 0, 0, 0);
  od = __builtin_amdgcn_mfma_f32_32x32x16_bf16(pa2, PK(l2, h2), od, 0, 0, 0);
  od = __builtin_amdgcn_mfma_f32_32x32x16_bf16(pa3, PK(l3, h3), od, 0, 0, 0);
#undef PK
}
__device__ __forceinline__ void pv_d0(f32x16* o, int vb, bf16x8 pa0, bf16x8 pa1, bf16x8 pa2, bf16x8 pa3) {
  pv_one<0>(o[0], vb, pa0, pa1, pa2, pa3); pv_one<1>(o[1], vb, pa0, pa1, pa2, pa3); pv_one<2>(o[2], vb, pa0, pa1, pa2, pa3); pv_one<3>(o[3], vb, pa0, pa1, pa2, pa3);
}

struct AUnit {
  const bf16* Q;
  const bf16* K1; const bf16* V1; int s1, n1;
  const bf16* K2; const bf16* V2; int s2, n2;
  bf16* O;
  int rlo, qa;
  const float* rpb;
};

template <int KIND, int PASS>
__device__ __forceinline__ void attn_unit(const AUnit& U, LAS char* lds, int tid_in, float lam, float onemli, const float* dg, float* stash) {
  int tid = tid_in; asm volatile("" : "+v"(tid));
  constexpr int ND0 = (KIND == 2) ? 4 : 8;
  constexpr float SCALE = Sc<KIND>::SCALE;
  const int wid = __builtin_amdgcn_readfirstlane(tid >> 6), lane = tid & 63, r32 = lane & 31, hi = lane >> 5;
  LAS char* V_lds = lds; LAS char* K_lds = lds + 2 * SHM_V;
  LAS float* wsl = (LAS float*)(lds + OFF_WS) + wid * 64; LAS float* li_l = wsl; LAS float* al_l = wsl + 32;
  LAS float* btab = (LAS float*)(lds + OFF_BT);
  const int NT = U.n1 + U.n2;
  const int sr = tid >> 4, sc = (tid & 15) * 8, vst0 = v_st(sr, sc), vst1 = v_st(32 + sr, sc);
  const int vb0 = (int)(unsigned)(uintptr_t)V_lds + v_rd_base(lane);
  int na_rq = 0, na_r0 = 0, na_t = 0, na_b = 0;
  if (KIND == 1) {
    for (int i = tid; i < 576; i += 512) btab[i] = (i >= 48 && i < 48 + 465) ? U.rpb[i - 48] * (1.0f / SCALE) : 0.f;
    const int cq = 32 * (wid & 1) + r32; na_rq = 4 * U.qa + (wid >> 1); na_r0 = min(max(na_rq - 4, 0), 8);
    na_t = 4 * hi - min(max(cq - 8, 0), 48); na_b = 48 + 4 * hi - cq + 15;
  }
  {
  constexpr int pass = PASS; constexpr int dbase = (KIND == 2) ? PASS * 64 : 0;
  float m_reg = -1e30f, l_reg = 0; f32x16 o[4] = {}; bf16x8 qr[ND0];
  { const bf16* Qw = U.Q + (size_t)(wid * QBLK + r32) * DIN + hi * 8 + dbase;
#pragma unroll
    for (int d0 = 0; d0 < ND0; ++d0) qr[d0] = *(const bf16x8*)(Qw + d0 * 16); }
  struct { bf16x8 vs0, vs1, ks0, ks1; } sr_[2];
#define TILE_PTRS(j) const bool s2_ = (j) >= U.n1; const int tt_ = s2_ ? (j) - U.n1 : (j); const int st_ = s2_ ? U.s2 : U.s1; \
    const bf16* Kt_ = (s2_ ? U.K2 : U.K1) + (size_t)tt_ * 64 * st_; const bf16* Vt_ = (s2_ ? U.V2 : U.V1) + (size_t)tt_ * 64 * st_;
#define SLOAD(i, j) do { TILE_PTRS(j) sr_[i].vs0 = *(const bf16x8*)(Vt_ + (size_t)sr * st_ + sc); sr_[i].vs1 = *(const bf16x8*)(Vt_ + (size_t)(32 + sr) * st_ + sc); \
    sr_[i].ks0 = *(const bf16x8*)(Kt_ + (size_t)sr * st_ + sc); sr_[i].ks1 = *(const bf16x8*)(Kt_ + (size_t)(32 + sr) * st_ + sc); } while (0)
#define SWRITE(b, i) do { *(LAS bf16x8*)(V_lds + (b) * SHM_V + vst0) = sr_[i].vs0; *(LAS bf16x8*)(V_lds + (b) * SHM_V + vst1) = sr_[i].vs1; const int kc = sc * 2; \
    *(LAS bf16x8*)(K_lds + (b) * SHM_K + KSWZ(sr, kc)) = sr_[i].ks0; *(LAS bf16x8*)(K_lds + (b) * SHM_K + KSWZ(32 + sr, kc)) = sr_[i].ks1; } while (0)
#define SWAIT() asm volatile("s_waitcnt vmcnt(4)" ::: "memory")
#define RESC(a) do { if (__any((a) < 1.f)) { if (hi == 0) al_l[r32] = (a); asm volatile("s_waitcnt lgkmcnt(0)" ::: "memory"); \
    _Pragma("unroll") for (int d = 0; d < 4; ++d) _Pragma("unroll") for (int r = 0; r < 16; ++r) o[d][r] *= al_l[crow(r, hi)]; } } while (0)
#define NABIAS(P0, P1, j) do { if (KIND == 1 && (j) >= U.n1) { const int rk = U.rlo + (j) - U.n1; const bool inw = (unsigned)(rk - na_r0) < 8u; \
    const int dr = min(max(rk - na_rq + 7, 0), 14); const LAS float* bp = btab + dr * 31 + na_b; const int tt = inw ? na_t : 1000; \
    _Pragma("unroll") for (int r = 0; r < 16; ++r) { const int co = (r & 3) + 8 * (r >> 2); \
      P0[r] = ((unsigned)(co + tt) < 16u) ? P0[r] + bp[co] : -1e30f; P1[r] = ((unsigned)(co + 32 + tt) < 16u) ? P1[r] + bp[co + 32] : -1e30f; } } } while (0)
  f32x16 pA0, pA1, pB0, pB1; float mnA, mnB, alA, alB; bf16x8 pa0, pa1, pa2, pa3;
  constexpr int SE = 0, SO = 1;
  __syncthreads();
  SLOAD(SE, 0); asm volatile("s_waitcnt vmcnt(0)" ::: "memory"); SWRITE(0, SE); __syncthreads();
  qkt<ND0>(pA0, pA1, K_lds, qr, r32, hi, dbase); NABIAS(pA0, pA1, 0); partialSM<KIND>(pA0, pA1, m_reg, mnA, alA);
  SLOAD(SO, 1); if (2 < NT) SLOAD(SE, 2);
  SWAIT(); SWRITE(1, SO); __syncthreads();
  for (int j = 1; j + 1 < NT; j += 2) {
    SBAR(); qkt<ND0>(pB0, pB1, K_lds + SHM_K, qr, r32, hi, dbase);
    finishSM(pA0, pA1, alA, l_reg, pa0, pa1, pa2, pa3); SBAR();
    SLOAD(SO, (j + 2 < NT) ? j + 2 : j); SBAR();
    pv_d0(o, vb0, pa0, pa1, pa2, pa3); NABIAS(pB0, pB1, j); partialSM<KIND>(pB0, pB1, m_reg, mnB, alB);
    __syncthreads(); SWAIT(); SWRITE(0, SE);
    RESC(alB); __syncthreads();
    SBAR(); qkt<ND0>(pA0, pA1, K_lds, qr, r32, hi, dbase);
    finishSM(pB0, pB1, alB, l_reg, pa0, pa1, pa2, pa3); SBAR();
    if (j + 3 < NT) SLOAD(SE, j + 3); SBAR();
    pv_d0(o, vb0 + SHM_V, pa0, pa1, pa2, pa3); NABIAS(pA0, pA1, j + 1); partialSM<KIND>(pA0, pA1, m_reg, mnA, alA);
    __syncthreads(); SWAIT(); SWRITE(1, SO);
    RESC(alA); __syncthreads();
  }
  SBAR(); qkt<ND0>(pB0, pB1, K_lds + SHM_K, qr, r32, hi, dbase);
  finishSM(pA0, pA1, alA, l_reg, pa0, pa1, pa2, pa3); SBAR();
  pv_d0(o, vb0, pa0, pa1, pa2, pa3); NABIAS(pB0, pB1, NT - 1); partialSM<KIND>(pB0, pB1, m_reg, mnB, alB);
  __syncthreads(); RESC(alB);
  finishSM(pB0, pB1, alB, l_reg, pa0, pa1, pa2, pa3); SBAR();
  pv_d0(o, vb0 + SHM_V, pa0, pa1, pa2, pa3);
  asm volatile("s_waitcnt vmcnt(0)" ::: "memory");
  if (hi == 0) li_l[r32] = l_reg; asm volatile("s_waitcnt lgkmcnt(0)" ::: "memory");
  float rli[16];
#pragma unroll
  for (int r = 0; r < 16; ++r) rli[r] = __builtin_amdgcn_rcpf(li_l[crow(r, hi)]);
  if (KIND != 2) {
    bf16* Ow = U.O + (size_t)(wid * QBLK) * DM;
#pragma unroll
    for (int r = 0; r < 16; ++r) { const int orow = crow(r, hi);
#pragma unroll
      for (int d0 = 0; d0 < 4; ++d0) Ow[(size_t)orow * DM + d0 * 32 + r32] = (bf16)f2bf(o[d0][r] * rli[r]); }
  } else if (pass == 0) {
    f32x4* sp = (f32x4*)(stash + (size_t)tid * 64);
#pragma unroll
    for (int d0 = 0; d0 < 4; ++d0)
#pragma unroll
      for (int r4 = 0; r4 < 4; ++r4) sp[d0 * 4 + r4] = (f32x4){o[d0][4 * r4] * rli[4 * r4], o[d0][4 * r4 + 1] * rli[4 * r4 + 1], o[d0][4 * r4 + 2] * rli[4 * r4 + 2], o[d0][4 * r4 + 3] * rli[4 * r4 + 3]};
  } else {
    float gcol[4];
#pragma unroll
    for (int d0 = 0; d0 < 4; ++d0) gcol[d0] = dg[d0 * 32 + r32] * onemli;
    bf16* Ow = U.O + (size_t)(wid * QBLK) * DM;
#pragma unroll
    for (int r = 0; r < 16; ++r) {
      float v[4]; float ss = 0.f;
#pragma unroll
      for (int d0 = 0; d0 < 4; ++d0) { v[d0] = stash[(size_t)tid * 64 + d0 * 16 + r] - lam * (o[d0][r] * rli[r]); ss += v[d0] * v[d0]; }
#pragma unroll
      for (int off = 1; off < 32; off <<= 1) ss += __shfl_xor(ss, off);
      const float rs = 1.0f / sqrtf(ss * (1.0f / 128.0f) + EPS);
      const int orow = crow(r, hi);
#pragma unroll
      for (int d0 = 0; d0 < 4; ++d0) Ow[(size_t)orow * DM + d0 * 32 + r32] = (bf16)f2bf(v[d0] * rs * gcol[d0]);
      asm volatile("" ::: "memory");
    }
  }
  }
#undef TILE_PTRS
#undef SLOAD
#undef SWRITE
#undef SWAIT
#undef RESC
#undef NABIAS
}
#undef KSWZ
#undef SBAR
}

constexpr int CW_ATTQ = 2048;
constexpr size_t WS_STASH = 896 * MiB;
constexpr size_t WS_END2 = 928 * MiB;

__device__ __forceinline__ int attq_next(unsigned* ctr, LAS char* lds, int tid) {
  LAS int* slot = (LAS int*)(lds + att::OFF_Q);
  __syncthreads();
  if (tid == 0) *slot = (int)__hip_atomic_fetch_add(ctr, 1u, __ATOMIC_RELAXED, __HIP_MEMORY_SCOPE_AGENT);
  __syncthreads();
  return *slot;
}

__device__ __forceinline__ void ph_attn(CArgs* a, const Ctx& X, int l) {
  unsigned char* ws = a->ws;
  const bf16* QKV = (const bf16*)(ws + WS_QKV); bf16* AO = (bf16*)(ws + WS_AO);
  unsigned* ctl = (unsigned*)(ws + WS_CTL);
  LAS char* lds = (LAS char*)X.lds;
  float* stash = (float*)(ws + WS_STASH) + (size_t)blockIdx.x * 32768;
  const float li = lambda_init_of(l);
  const float* lamv = a->in[I_LAM] + l * 256;
  const float lam = expf(wave_sum(lamv[X.lane] * lamv[64 + X.lane])) - expf(wave_sum(lamv[128 + X.lane] * lamv[192 + X.lane])) + li;
  const float* dg = a->in[I_DG] + l * 128;
#ifndef AMASK
#define AMASK 7
#endif
  if (AMASK & 1)
  for (;;) {
    const int i = attq_next(ctl + CW_ATTQ + 64 * (3 * l + 0), lds, X.tid); if (i >= 192) break;
    att::AUnit U{};
    if (i < 128) { const int b = i >> 4, h = (i >> 2) & 3, qb = i & 3; const size_t r0 = (size_t)NCTX + b * LAT_T;
      U.Q = QKV + (r0 + qb * 256) * DIN + C_DQ + h * 128; U.O = AO + (r0 + qb * 256) * DM + AO_D + h * 128;
      const size_t co = ((size_t)(b * DEPTH + l) * PAST) * 512 + h * 128;
      U.K1 = (const bf16*)(ws + WS_CDK) + co; U.V1 = (const bf16*)(ws + WS_CDV) + co; U.s1 = 512; U.n1 = 4;
      U.K2 = QKV + r0 * DIN + C_DK + h * 128; U.V2 = QKV + r0 * DIN + C_DV + h * 128; U.s2 = DIN; U.n2 = 16;
    } else { const int j = i - 128, b = j >> 2, h = j & 3; const size_t r0 = (size_t)b * CTX_T;
      U.Q = QKV + r0 * DIN + C_DQ + h * 128; U.O = AO + r0 * DM + AO_D + h * 128;
      U.K1 = QKV + r0 * DIN + C_DK + h * 128; U.V1 = QKV + r0 * DIN + C_DV + h * 128; U.s1 = DIN; U.n1 = 4; U.K2 = U.K1; U.V2 = U.V1; U.s2 = DIN; U.n2 = 0; }
    #ifndef DPASS
#define DPASS 3
#endif
    if (DPASS & 1) att::attn_unit<2, 0>(U, lds, X.tid, lam, 1.0f - li, dg, stash);
    if (DPASS & 2) att::attn_unit<2, 1>(U, lds, X.tid, lam, 1.0f - li, dg, stash);
  }
  if (AMASK & 2)
  for (;;) {
    const int i = attq_next(ctl + CW_ATTQ + 64 * (3 * l + 1), lds, X.tid); if (i >= 128) break;
    att::AUnit U{};
    const int b = i >> 4, h = (i >> 2) & 3, qb = i & 3; const size_t r0 = (size_t)NCTX + b * LAT_T;
    U.Q = QKV + (r0 + qb * 256) * DIN + C_NAQ + h * 128; U.O = AO + (r0 + qb * 256) * DM + AO_NA + h * 128;
    const size_t co = ((size_t)(b * DEPTH + l) * PAST) * 512 + h * 128;
    U.K1 = (const bf16*)(ws + WS_CNAK) + co; U.V1 = (const bf16*)(ws + WS_CNAV) + co; U.s1 = 512; U.n1 = 4;
    U.rlo = (qb == 0) ? 0 : (qb == 1) ? 0 : (qb == 2) ? 4 : 8; U.n2 = (qb == 0 || qb == 3) ? 8 : 12; U.qa = qb;
    U.K2 = QKV + (r0 + U.rlo * 64) * DIN + C_NAK + h * 128; U.V2 = QKV + (r0 + U.rlo * 64) * DIN + C_NAV + h * 128; U.s2 = DIN;
    U.rpb = a->in[I_RPB] + (size_t)(l * 4 + h) * 465;
    att::attn_unit<1, 0>(U, lds, X.tid, 0.f, 0.f, nullptr, nullptr);
  }
  if (AMASK & 4)
  for (;;) {
    const int i = attq_next(ctl + CW_ATTQ + 64 * (3 * l + 2), lds, X.tid); if (i >= 448) break;
    att::AUnit U{};
    if (i < 256) { const int b = i >> 5, hq = (i >> 2) & 7, qb = i & 3, kvh = hq >> 2; const size_t r0 = (size_t)NCTX + b * LAT_T;
      U.Q = QKV + (r0 + qb * 256) * DIN + C_GQ + hq * 128; U.O = AO + (r0 + qb * 256) * DM + AO_G + hq * 128;
      const size_t co = ((size_t)(b * DEPTH + l) * PAST) * 256 + kvh * 128;
      U.K1 = (const bf16*)(ws + WS_CGK) + co; U.V1 = (const bf16*)(ws + WS_CGV) + co; U.s1 = 256; U.n1 = 4;
      U.K2 = QKV + r0 * DIN + C_GK + kvh * 128; U.V2 = QKV + r0 * DIN + C_GV + kvh * 128; U.s2 = DIN; U.n2 = 16;
    } else if (i < 384) { const int j = i - 256, b = j >> 3, hq = j & 7, kvh = hq >> 2; const size_t r0 = (size_t)b * CTX_T;
      U.Q = QKV + r0 * DIN + C_GQ + hq * 128; U.O = AO + r0 * DM + AO_G + hq * 128;
      U.K1 = QKV + r0 * DIN + C_GK + kvh * 128; U.V1 = QKV + r0 * DIN + C_GV + kvh * 128; U.s1 = DIN; U.n1 = 4; U.K2 = U.K1; U.V2 = U.V1; U.s2 = DIN; U.n2 = 0;
    } else { const int j = i - 384, b = j >> 2, h = j & 3; const size_t r0 = (size_t)b * CTX_T;
      U.Q = QKV + r0 * DIN + C_NAQ + h * 128; U.O = AO + r0 * DM + AO_NA + h * 128;
      U.K1 = QKV + r0 * DIN + C_NAK + h * 128; U.V1 = QKV + r0 * DIN + C_NAV + h * 128; U.s1 = DIN; U.n1 = 4; U.K2 = U.K1; U.V2 = U.V1; U.s2 = DIN; U.n2 = 0; }
    att::attn_unit<0, 0>(U, lds, X.tid, 0.f, 0.f, nullptr, nullptr);
  }
}

constexpr int NPHASE = 2 + 8 * DEPTH;
#ifndef ATTN_NAIVE
#define ATTN_NAIVE 0
#endif
#ifndef MK_SINGLE
#define MK_SINGLE 1
#endif
__global__ void __launch_bounds__(NTHREADS, 2) fwd(Args args_unused) {
    extern __shared__ __attribute__((aligned(16))) unsigned char lds_raw[];
#define CTX_HERE() Ctx X; { int t_ = threadIdx.x; asm volatile("" : "+v"(t_)); X.lds = (LAS unsigned char*)lds_raw; X.tid = t_; X.lane = t_ & 63; X.wave = __builtin_amdgcn_readfirstlane(t_ >> 6); \
    X.G = gridDim.x; const int bx_ = blockIdx.x; X.vcu = (X.G % 8 == 0) ? (bx_ % 8) * (X.G / 8) + bx_ / 8 : bx_; X.gw = X.vcu * NWAVES + X.wave; X.NGW = X.G * NWAVES; }
    LAS unsigned char* const lds0 = (LAS unsigned char*)lds_raw;
    for (int u = threadIdx.x; u < (LDS_BYTES - LDSCTL_OFF) / 4; u += NTHREADS) ((LAS unsigned*)(lds0 + LDSCTL_OFF))[u] = 0u;
    __syncthreads();
    int lo, hi; XcdBarrier bar;
    { CArgs* A = args_here(); lo = A->ph_lo; hi = A->ph_hi; unsigned* ctl = (unsigned*)(A->ws + WS_CTL);
      bar.bar = ctl + CW_BAR; bar.x = 0; bar.st = nullptr;
      if (hi - lo > 1) bar = xcd_barrier_post(ctl + CW_BAR, (volatile LAS unsigned*)(lds0 + MISC_OFF) + 8); }
#ifndef PHMASK
#define PHMASK 0xffff
#endif
#define IN(k) (lo <= (k) && (k) < hi)
#define ON(n) ((PHMASK >> (n)) & 1)
#define SEAM(k) do { if (IN(k) && IN((k) + 1)) xcd_barrier(bar); } while (0)

    if (ON(0) && IN(0)) { CTX_HERE(); CArgs* A = args_here(); ph_prologue(A, X); SEAM(0); }
    if (ON(1) && IN(1)) { CTX_HERE(); CArgs* A = args_here(); norm_rows<false, true>(A, X, nullptr, nullptr, nullptr, 0, A->in[I_NORMG], (const float*)(A->ws + WS_MOD), 0, 2048, true); SEAM(1); }

    for (int l = 0; l < DEPTH; ++l) {
        const int pb = 2 + 8 * l;
        if (ON(2) && IN(pb + 0)) {
            CArgs* A = args_here(); unsigned char* ws = A->ws;
            pg8::Gemm g{(const bf16*)(ws + WS_H), (const bf16*)(ws + WS_WIN) + (size_t)l * DIN * DM, MTOK, DIN, DM}; pg8::StaticOrder S; S.init(MTOK, DIN, (int)gridDim.x, (int)blockIdx.x);
            pg8::EpiBf16<0> E{(bf16*)(ws + WS_QKV), DIN};
            pg8::gemm_phase<pg8::EpiBf16<0>, pg8::StaticOrder, true, true>(lds0 + RING_OFF, g, S, E);
            SEAM(pb + 0);
        }
        if (ON(3) && IN(pb + 1)) { CTX_HERE(); CArgs* A = args_here(); ph_fixup(A, X, l); SEAM(pb + 1); }
        if (ON(4) && IN(pb + 2)) { CTX_HERE(); CArgs* A = args_here();
#if ATTN_NAIVE
            ph_attn_naive(A, X, l);
#else
            ph_attn(A, X, l);
#endif
            SEAM(pb + 2); }
        if (ON(5) && IN(pb + 3)) {
            CArgs* A = args_here(); unsigned char* ws = A->ws;
            pg8::Gemm g{(const bf16*)(ws + WS_AO), (const bf16*)(ws + WS_WOUT) + (size_t)l * DM * DM, MTOK, DM, DM}; pg8::StaticOrder S; S.init(MTOK, DM, (int)gridDim.x, (int)blockIdx.x);
            pg8::EpiF32 E{(float*)(ws + WS_O2), DM};
            pg8::gemm_phase<pg8::EpiF32, pg8::StaticOrder, true, true>(lds0 + RING_OFF, g, S, E);
            SEAM(pb + 3);
        }
        if (ON(6) && IN(pb + 4)) { CTX_HERE(); CArgs* A = args_here(); const float* normg = A->in[I_NORMG]; const float* modl = (const float*)(A->ws + WS_MOD) + (size_t)l * 9 * NMODW;
            norm_rows<true, false>(A, X, (const float*)(A->ws + WS_O2), normg + (size_t)(l * 4 + 1) * DM, modl, 4096, normg + (size_t)(l * 4 + 2) * DM, modl, 6144, 8192, true); SEAM(pb + 4); }
        if (ON(7) && IN(pb + 5)) {
            CArgs* A = args_here(); unsigned char* ws = A->ws;
            pg8::Gemm g{(const bf16*)(ws + WS_H), (const bf16*)(ws + WS_WUP) + (size_t)l * DFF * DM, MTOK, DFF, DM}; pg8::StaticOrder S; S.init(MTOK, DFF, (int)gridDim.x, (int)blockIdx.x);
            pg8::EpiBf16<2> E{(bf16*)(ws + WS_U), DFF};
            pg8::gemm_phase<pg8::EpiBf16<2>, pg8::StaticOrder, true, true>(lds0 + RING_OFF, g, S, E);
            SEAM(pb + 5);
        }
        if (ON(8) && IN(pb + 6)) {
            CArgs* A = args_here(); unsigned char* ws = A->ws;
            pg8::Gemm g{(const bf16*)(ws + WS_U), (const bf16*)(ws + WS_WDN) + (size_t)l * DM * DFF, MTOK, DM, DFF}; pg8::StaticOrder S; S.init(MTOK, DM, (int)gridDim.x, (int)blockIdx.x);
            pg8::EpiF32 E{(float*)(ws + WS_O2), DM};
            pg8::gemm_phase<pg8::EpiF32, pg8::StaticOrder, true, true>(lds0 + RING_OFF, g, S, E);
            SEAM(pb + 6);
        }
        if (ON(9) && IN(pb + 7)) {
            CTX_HERE(); CArgs* A = args_here(); const float* normg = A->in[I_NORMG]; const float* mod_all = (const float*)(A->ws + WS_MOD);
            const int ln = (l + 1 < DEPTH) ? l + 1 : l;
            norm_rows<true, false>(A, X, (const float*)(A->ws + WS_O2), normg + (size_t)(l * 4 + 3) * DM, mod_all + (size_t)l * 9 * NMODW, 10240, normg + (size_t)(ln * 4 + 0) * DM, mod_all + (size_t)ln * 9 * NMODW, 0, 2048, l + 1 < DEPTH);
            SEAM(pb + 7);
        }
    }
#undef IN
#undef SEAM
}

extern "C" void kernel_launch(void* const* d_in, const int* in_sizes, int n_in, void* d_out, int out_size, void* d_ws, size_t ws_size, hipStream_t stream) {
    static int grid = 0;
    if (grid == 0) {
        if (n_in != 22 || out_size != (int)OUT_END || ws_size < WS_END2) { fprintf(stderr, "kernel_launch: unexpected shapes: n_in %d out %d ws %zu\n", n_in, out_size, ws_size); grid = -1; return; }
        int dev = 0, cus = 0, per_cu = 0;
        if (hipGetDevice(&dev) != hipSuccess || hipDeviceGetAttribute(&cus, hipDeviceAttributeMultiprocessorCount, dev) != hipSuccess) { grid = -1; return; }
        if (hipFuncSetAttribute((const void*)fwd, hipFuncAttributeMaxDynamicSharedMemorySize, LDS_BYTES) != hipSuccess) { fprintf(stderr, "kernel_launch: hipFuncSetAttribute failed\n"); grid = -1; return; }
        if (hipOccupancyMaxActiveBlocksPerMultiprocessor(&per_cu, (const void*)fwd, NTHREADS, LDS_BYTES) != hipSuccess || per_cu < 1) fprintf(stderr, "kernel_launch: occupancy query says %d\n", per_cu);
        (void)hipGetLastError();
        grid = cus;
    }
    if (grid < 0) return;
    (void)hipMemsetAsync((char*)d_ws + WS_CTL, 0, CTL_ZERO_BYTES, stream);
    Args a{};
    for (int i = 0; i < 22; ++i) a.in[i] = (const float*)d_in[i];
    a.out = (float*)d_out; a.ws = (unsigned char*)d_ws;
#if MK_SINGLE
    a.ph_lo = 0; a.ph_hi = NPHASE;
    hipLaunchKernelGGL(fwd, dim3(grid), dim3(NTHREADS), LDS_BYTES, stream, a);
#else
    for (int p = 0; p < NPHASE; ++p) { a.ph_lo = p; a.ph_hi = p + 1; hipLaunchKernelGGL(fwd, dim3(grid), dim3(NTHREADS), LDS_BYTES, stream, a); }
#endif
    const hipError_t le = hipPeekAtLastError();
    if (le != hipSuccess) fprintf(stderr, "kernel_launch: launch failed: %s\n", hipGetErrorName(le));
}
```

```cpp
#include <hip/hip_runtime.h>
#include <cstdio>
#include <cstdint>
#include <cmath>
namespace pg8 {
#define PG8_LAS __attribute__((address_space(3)))
typedef unsigned short bf16_t;
typedef short bf16x8 __attribute__((ext_vector_type(8)));
typedef float f32x4 __attribute__((ext_vector_type(4)));
typedef unsigned u32x4 __attribute__((ext_vector_type(4)));
constexpr int BM = 256, BK = 64, HALF = 128, HTB = HALF * BK * 2  , STAGE_BYTES = 8 * HTB, NXCD = 8, WGM = 8;

__host__ __device__ __forceinline__ int lds_byte(int r, int c) { const int st = (r >> 4) * 2 + (c >> 5), rr = r & 15, cc = c & 31, ob = rr * 64 + cc * 2; return st * 1024 + (ob ^ (((ob >> 9) & 1) << 5)); }
__host__ __device__ __forceinline__ void stage_rc(int b, int& R, int& C) { const int st = b / 1024, sb = b % 1024, swz = sb ^ (((sb >> 9) & 1) << 5); R = (st >> 1) * 16 + swz / 64; C = (st & 1) * 32 + (swz % 64) / 2; }
__host__ __device__ __forceinline__ int perm32(int rho) { const int n = rho >> 4, i = rho & 15; return 8 * (i >> 2) + 4 * n + (i & 3); }

struct Unit { int pm, pn, k0, nt; };
struct Gemm { const bf16_t* A; const bf16_t* Bt; int M, N, K; };

struct StaticOrder {
    static constexpr bool SPLITK = false;
    int nM, nN, nwg, G, c;
    __host__ __device__ void init(int M, int N, int G_, int c_) { nM = M / BM; nN = N / BM; nwg = nM * nN; G = G_; c = c_; }
    __host__ __device__ bool next(int i, Unit& u) const {
        const long L = (long)i * G + c; if (L >= nwg) return false;
        int wgid = (int)L; { const int q = nwg / NXCD, r = nwg % NXCD, xcd = wgid % NXCD, off = wgid / NXCD; wgid = (xcd < r ? xcd * (q + 1) : r * (q + 1) + (xcd - r) * q) + off; }
        const int nig = WGM * nN, gid = wgid / nig, fm = gid * WGM, gsz = (nM - fm) < WGM ? (nM - fm) : WGM;
        u.pm = fm + ((wgid % nig) % gsz); u.pn = (wgid % nig) / gsz; return true;
    }
    __device__ __forceinline__ void a_ready(const Unit&) const {}
    __device__ __forceinline__ void done(const Unit&) const {}
};

__device__ __forceinline__ unsigned cvt_pk_bf16(float lo, float hi) { unsigned r; asm volatile("v_cvt_pk_bf16_f32 %0, %1, %2" : "=v"(r) : "v"(lo), "v"(hi)); return r; }
#ifndef EPI_WT
#define EPI_WT 0
#endif
typedef unsigned u32x2w __attribute__((ext_vector_type(2)));
__device__ __forceinline__ void st16(void* p, u32x4 w) { if (EPI_WT) asm volatile("global_store_dwordx4 %0, %1, off sc1" :: "v"(p), "v"(w) : "memory"); else *(u32x4*)p = w; }
__device__ __forceinline__ void st16f(void* p, f32x4 w) { if (EPI_WT) asm volatile("global_store_dwordx4 %0, %1, off sc1" :: "v"(p), "v"(w) : "memory"); else __builtin_nontemporal_store(w, (f32x4*)p); }
__device__ __forceinline__ void st8(void* p, u32x2w w) { if (EPI_WT) asm volatile("global_store_dwordx2 %0, %1, off sc1" :: "v"(p), "v"(w) : "memory"); else *(u32x2w*)p = w; }
struct EpiF32 {
    static constexpr bool AFTER_DRAIN = false; static constexpr int NKIND = 1; static __device__ __forceinline__ int kind(const Unit&) { return 0; } static __device__ __forceinline__ int browk(int, int R) { return brow(R); } static __device__ __forceinline__ int brow(int R) { return R; }
    float* C; int ldc;
    __device__ __forceinline__ void operator()(const f32x4 (&acc)[2][2][4][2], const Unit& u, int wr, int wc, int fr_in, int fq) const {
        int fr = fr_in; asm volatile("" : "+v"(fr));
        const int row0 = u.pm * BM + wr * 64 + fr, col0 = u.pn * BM + wc * 32 + 4 * fq;
#pragma unroll
        for (int ai = 0; ai < 2; ++ai)
#pragma unroll
            for (int m = 0; m < 4; ++m) { float* rowp = C + (size_t)(row0 + ai * HALF + m * 16) * ldc + col0;
#pragma unroll
                for (int bj = 0; bj < 2; ++bj)
#pragma unroll
                    for (int n = 0; n < 2; ++n) *(f32x4*)(rowp + bj * HALF + n * 16) = acc[ai][bj][m][n]; }
    }
};
template <int ACT  > struct EpiBf16 {
    static constexpr bool AFTER_DRAIN = false; static constexpr int NKIND = 1; static __device__ __forceinline__ int kind(const Unit&) { return 0; } static __device__ __forceinline__ int browk(int, int R) { return brow(R); } static __device__ __forceinline__ int brow(int R) { return (R & ~31) + perm32(R & 31); }
    bf16_t* O; int ldc;
    __device__ __forceinline__ void operator()(const f32x4 (&acc)[2][2][4][2], const Unit& u, int wr, int wc, int fr_in, int fq) const {
        int fr = fr_in; asm volatile("" : "+v"(fr));
        const int row0 = u.pm * BM + wr * 64 + fr; const int col0 = u.pn * BM + wc * 32 + 8 * fq;
#pragma unroll
        for (int ai = 0; ai < 2; ++ai)
#pragma unroll
            for (int m = 0; m < 4; ++m) { bf16_t* rowp = O + (size_t)(row0 + ai * HALF + m * 16) * ldc + col0;
#pragma unroll
                for (int bj = 0; bj < 2; ++bj) { f32x4 v0 = acc[ai][bj][m][0], v1 = acc[ai][bj][m][1];
                    if (ACT == 2) {
#pragma unroll
                        for (int j = 0; j < 4; ++j) { const float a = fmaxf(v0[j], 0.f), b = fmaxf(v1[j], 0.f); v0[j] = a * a; v1[j] = b * b; } }
                    u32x4 w; w.x = cvt_pk_bf16(v0[0], v0[1]); w.y = cvt_pk_bf16(v0[2], v0[3]); w.z = cvt_pk_bf16(v1[0], v1[1]); w.w = cvt_pk_bf16(v1[2], v1[3]);
                    st16(rowp + bj * HALF, w); } }
    }
};


template <int MB> struct EpiBf16R {
    static constexpr bool AFTER_DRAIN = false; static constexpr int NKIND = 1; static __device__ __forceinline__ int kind(const Unit&) { return 0; } static __device__ __forceinline__ int browk(int, int R) { return brow(R); } static __device__ __forceinline__ int brow(int R) { return (R & ~31) + perm32(R & 31); }
    bf16_t* O; int ldc;
    __device__ __forceinline__ void operator()(const f32x4 (&acc)[2][2][4][2], const Unit& u, int wr, int wc, int fr_in, int fq) const {
        int fr = fr_in; asm volatile("" : "+v"(fr));
        const int row0 = u.pm * (64 * MB) + wr * (16 * MB) + fr; const int col0 = u.pn * BM + wc * 32 + 8 * fq;
#pragma unroll
        for (int ai = 0; ai < 2; ++ai)
#pragma unroll
            for (int m = 0; m < MB; ++m) { bf16_t* rowp = O + (size_t)(row0 + ai * (32 * MB) + m * 16) * ldc + col0;
#pragma unroll
                for (int bj = 0; bj < 2; ++bj) { const f32x4 v0 = acc[ai][bj][m][0], v1 = acc[ai][bj][m][1];
                    u32x4 w; w.x = cvt_pk_bf16(v0[0], v0[1]); w.y = cvt_pk_bf16(v0[2], v0[3]); w.z = cvt_pk_bf16(v1[0], v1[1]); w.w = cvt_pk_bf16(v1[2], v1[3]);
                    st16(rowp + bj * HALF, w); } }
    }
};

struct SplitTailOrder {
    static constexpr bool SPLITK = true;
    int G, c, ntK;
    __device__ __forceinline__ void init(int K, int G_, int c_) { G = G_; c = c_; ntK = K / BK; }
    __device__ __forceinline__ bool next(int i, Unit& u) const {
        const int L = i * G + c; if (L >= 512) return false;
        const bool tail = L >= 256; const int T = tail ? L - 256 : L, x = T & 7, j = T >> 3;
        u.pm = tail ? 32 + x * 2 + (j >> 4) : x * 4 + (j >> 3); u.pn = tail ? ((j & 15) >> 1) : (j & 7);
        u.nt = tail ? (ntK >> 1) : ntK; u.k0 = tail ? (j & 1) * (ntK >> 1) * BK : 0;
        return true;
    }
    __device__ __forceinline__ void a_ready(const Unit&) const {}
    __device__ __forceinline__ void done(const Unit&) const {}
};
struct EpiBf16Split {
    static constexpr bool AFTER_DRAIN = false; static constexpr int NKIND = 1; static __device__ __forceinline__ int kind(const Unit&) { return 0; } static __device__ __forceinline__ int browk(int, int R) { return brow(R); } static __device__ __forceinline__ int brow(int R) { return (R & ~31) + perm32(R & 31); }
    bf16_t* O; bf16_t* O1;
    __device__ __forceinline__ void operator()(const f32x4 (&acc)[2][2][4][2], const Unit& u, int wr, int wc, int fr_in, int fq) const {
        int fr = fr_in; asm volatile("" : "+v"(fr));
        bf16_t* base = (u.k0 != 0) ? O1 + (size_t)(u.pm - 32) * BM * 2048 : O + (size_t)u.pm * BM * 2048;
        const int row0 = wr * 64 + fr; const int col0 = u.pn * BM + wc * 32 + 8 * fq;
#pragma unroll
        for (int ai = 0; ai < 2; ++ai)
#pragma unroll
            for (int m = 0; m < 4; ++m) { bf16_t* rowp = base + (size_t)(row0 + ai * HALF + m * 16) * 2048 + col0;
#pragma unroll
                for (int bj = 0; bj < 2; ++bj) { const f32x4 v0 = acc[ai][bj][m][0], v1 = acc[ai][bj][m][1];
                    u32x4 w; w.x = cvt_pk_bf16(v0[0], v0[1]); w.y = cvt_pk_bf16(v0[2], v0[3]); w.z = cvt_pk_bf16(v1[0], v1[1]); w.w = cvt_pk_bf16(v1[2], v1[3]);
                    st16(rowp + bj * HALF, w); } }
    }
};

typedef float f32x2e __attribute__((ext_vector_type(2)));
typedef unsigned u32x2 __attribute__((ext_vector_type(2)));
struct InOut { float* out; int l; };
struct EpiInP {
    static constexpr bool AFTER_DRAIN = false; static constexpr int NKIND = 1; static __device__ __forceinline__ int kind(const Unit&) { return 0; } static __device__ __forceinline__ int browk(int, int R) { return brow(R); } static __device__ __forceinline__ int brow(int R) { return (R & ~31) + perm32(R & 31); }
    bf16_t* O; float* out; int l;
    __device__ __forceinline__ void operator()(const f32x4 (&acc)[2][2][4][2], const Unit& u, int wr, int wc, int fr_in, int fq) const {
        int fr = fr_in; asm volatile("" : "+v"(fr));
        const int rin0 = wr * 64 + fr, col0 = u.pn * BM + wc * 32 + 8 * fq;
        float* ob = nullptr; int ow = 512;
        if (u.pm < 16) {
            if (u.pn >= 2 && u.pn <= 3) ob = out + 25165824 + (u.pn - 2) * 256; else if (u.pn >= 4 && u.pn <= 5) ob = out + 33554432 + (u.pn - 4) * 256;
            else if (u.pn == 11) { ob = out + 46137344; ow = 256; } else if (u.pn >= 16) ob = out + 58720256 + (u.pn - 16) * 256;
        }
#pragma unroll
        for (int ai = 0; ai < 2; ++ai)
#pragma unroll
            for (int m = 0; m < 4; ++m) { const int rin = rin0 + ai * HALF + m * 16; bf16_t* rowp = O + (size_t)(u.pm * BM + rin) * 4608 + col0;
#pragma unroll
                for (int bj = 0; bj < 2; ++bj) { const f32x4 v0 = acc[ai][bj][m][0], v1 = acc[ai][bj][m][1];
                    u32x4 w; w.x = cvt_pk_bf16(v0[0], v0[1]); w.y = cvt_pk_bf16(v0[2], v0[3]); w.z = cvt_pk_bf16(v1[0], v1[1]); w.w = cvt_pk_bf16(v1[2], v1[3]);
                    st16(rowp + bj * HALF, w);
                    if (ob) { float* d = ob + ((size_t)(u.pm * 4 + l) * 256 + rin) * ow + bj * HALF + wc * 32 + 8 * fq; st16f(d, v0); st16f(d + 4, v1); } } }
    }
};
struct EpiInG {
    static constexpr bool AFTER_DRAIN = false; static constexpr int NKIND = 1; static __device__ __forceinline__ int kind(const Unit&) { return 0; }
    static __device__ __forceinline__ int browk(int, int R) { return brow(R); } static __device__ __forceinline__ int brow(int R) { const int wc = R >> 5, n = (R >> 4) & 1, fq = (R >> 2) & 3, e = R & 3, g = 4 * wc + fq; return 4 * g + (g >= 8 ? 32 : 0) + 32 * n + e; }
    bf16_t* O; float* out; int l; const float* qg; const float* kg; const float* rope; PG8_LAS float* P;
    __device__ __forceinline__ void operator()(const f32x4 (&acc)[2][2][4][2], const Unit& u, int wr, int wc, int fr_in, int fq) const {
        int fr = fr_in; asm volatile("" : "+v"(fr));
        const int g = 4 * wc + fq, c = 4 * g + (g >= 8 ? 32 : 0);
        const int rin0 = wr * 64 + fr;
#pragma unroll
        for (int ai = 0; ai < 2; ++ai)
#pragma unroll
            for (int bj = 0; bj < 2; ++bj)
#pragma unroll
                for (int m = 0; m < 4; ++m) { const f32x4 a = acc[ai][bj][m][0], b = acc[ai][bj][m][1];
                    float s = (a[0] * a[0] + a[1] * a[1]) + (a[2] * a[2] + a[3] * a[3]) + (b[0] * b[0] + b[1] * b[1]) + (b[2] * b[2] + b[3] * b[3]);
                    s += __shfl_xor(s, 16); s += __shfl_xor(s, 32);
                    if (fq == 0) P[((ai * 2 + bj) * 128 + rin0 + m * 16) * 4 + wc] = s; }
        const float* gs = (u.pn == 10) ? kg : qg;
        const f32x4 gA = *(const f32x4*)(gs + c), gB = *(const f32x4*)(gs + c + 32);
        const bool lat = u.pm >= 16;
        const int fi = (wc < 2) ? c : c - 64;
        f32x4 cs[4][2];
#pragma unroll
        for (int k = 0; k < 4; ++k) { cs[k][0] = (f32x4){1.f, 0.f, 1.f, 0.f}; cs[k][1] = (f32x4){1.f, 0.f, 1.f, 0.f};
            if (lat) { const int pos = (wc < 2) ? 4 * (u.pm & 3) + 2 * (k & 1) + wr : 16 * k + fr; const float* rp = rope + (size_t)(pos * 48 + fi) * 2; cs[k][0] = *(const f32x4*)rp; cs[k][1] = *(const f32x4*)(rp + 4); } }
        asm volatile("s_waitcnt lgkmcnt(0)" ::: "memory"); __builtin_amdgcn_s_barrier(); asm volatile("" ::: "memory");
#pragma unroll
        for (int ai = 0; ai < 2; ++ai)
#pragma unroll
            for (int m = 0; m < 4; ++m) { const int rin = rin0 + ai * HALF + m * 16; bf16_t* rowp = O + (size_t)(u.pm * BM + rin) * 4608 + u.pn * BM + c;
                const f32x4 cs01 = (wc < 2) ? cs[ai][0] : cs[m][0], cs23 = (wc < 2) ? cs[ai][1] : cs[m][1];
#pragma unroll
                for (int bj = 0; bj < 2; ++bj) { const f32x4 t4 = *(const PG8_LAS f32x4*)(P + ((ai * 2 + bj) * 128 + rin0 + m * 16) * 4);
                    const float r = 1.0f / sqrtf(((t4[0] + t4[1]) + (t4[2] + t4[3])) * (1.0f / 128.0f) + 1e-6f);
                    const f32x4 x1 = acc[ai][bj][m][0] * r * gA, x2 = acc[ai][bj][m][1] * r * gB;
                    f32x4 y1, y2;
                    y1[0] = x1[0] * cs01[0] - x2[0] * cs01[1]; y2[0] = x2[0] * cs01[0] + x1[0] * cs01[1];
                    y1[1] = x1[1] * cs01[2] - x2[1] * cs01[3]; y2[1] = x2[1] * cs01[2] + x1[1] * cs01[3];
                    y1[2] = x1[2] * cs23[0] - x2[2] * cs23[1]; y2[2] = x2[2] * cs23[0] + x1[2] * cs23[1];
                    y1[3] = x1[3] * cs23[2] - x2[3] * cs23[3]; y2[3] = x2[3] * cs23[2] + x1[3] * cs23[3];
                    u32x2 w1, w2; w1.x = cvt_pk_bf16(y1[0], y1[1]); w1.y = cvt_pk_bf16(y1[2], y1[3]); w2.x = cvt_pk_bf16(y2[0], y2[1]); w2.y = cvt_pk_bf16(y2[2], y2[3]);
                    st8(rowp + bj * HALF, w1); st8(rowp + bj * HALF + 32, w2);
                    if (u.pn == 10 && !lat) { float* d = out + 41943040 + ((size_t)(u.pm * 4 + l) * 256 + rin) * 256 + bj * HALF + c; st16f(d, x1); st16f(d + 32, x2); } } }
    }
};
struct EpiInD {
    static constexpr bool AFTER_DRAIN = false; static constexpr int NKIND = 1; static __device__ __forceinline__ int kind(const Unit&) { return 0; }
    static __device__ __forceinline__ int browk(int, int R) { return brow(R); } static __device__ __forceinline__ int brow(int R) { const int wc = R >> 5, n = (R >> 4) & 1, fq = (R >> 2) & 3, e = R & 3; return 32 * wc + 4 * fq + 16 * n + e; }
    bf16_t* O; float* out; int l; const float* rope;
    __device__ __forceinline__ void operator()(const f32x4 (&acc)[2][2][4][2], const Unit& u, int wr, int wc, int fr_in, int fq) const {
        int fr = fr_in; asm volatile("" : "+v"(fr));
        const int c = 32 * wc + 4 * fq, rin0 = wr * 64 + fr;
        const bool lat = u.pm >= 16;
        float* ob = (!lat && u.pn >= 14) ? out + 50331648 + (u.pn - 14) * 256 : nullptr;
        f32x4 cs[4][2];
#pragma unroll
        for (int k = 0; k < 4; ++k) { cs[k][0] = (f32x4){1.f, 0.f, 1.f, 0.f}; cs[k][1] = (f32x4){1.f, 0.f, 1.f, 0.f};
            if (lat) { const int pos = (wc & 1) ? 16 * k + fr : 4 * (u.pm & 3) + 2 * (k & 1) + wr; const float* rp = rope + (size_t)(pos * 48 + 32 + 4 * fq) * 2; cs[k][0] = *(const f32x4*)rp; cs[k][1] = *(const f32x4*)(rp + 4); } }
#pragma unroll
        for (int ai = 0; ai < 2; ++ai)
#pragma unroll
            for (int m = 0; m < 4; ++m) { const int rin = rin0 + ai * HALF + m * 16; bf16_t* rowp = O + (size_t)(u.pm * BM + rin) * 4608 + u.pn * BM + c;
                const f32x4 cs01 = (wc & 1) ? cs[m][0] : cs[ai][0], cs23 = (wc & 1) ? cs[m][1] : cs[ai][1];
#pragma unroll
                for (int bj = 0; bj < 2; ++bj) { const f32x4 x1 = acc[ai][bj][m][0], x2 = acc[ai][bj][m][1];
                    f32x4 y1, y2;
                    y1[0] = x1[0] * cs01[0] - x2[0] * cs01[1]; y2[0] = x2[0] * cs01[0] + x1[0] * cs01[1];
                    y1[1] = x1[1] * cs01[2] - x2[1] * cs01[3]; y2[1] = x2[1] * cs01[2] + x1[1] * cs01[3];
                    y1[2] = x1[2] * cs23[0] - x2[2] * cs23[1]; y2[2] = x2[2] * cs23[0] + x1[2] * cs23[1];
                    y1[3] = x1[3] * cs23[2] - x2[3] * cs23[3]; y2[3] = x2[3] * cs23[2] + x1[3] * cs23[3];
                    u32x2 w1, w2; w1.x = cvt_pk_bf16(y1[0], y1[1]); w1.y = cvt_pk_bf16(y1[2], y1[3]); w2.x = cvt_pk_bf16(y2[0], y2[1]); w2.y = cvt_pk_bf16(y2[2], y2[3]);
                    st8(rowp + bj * HALF, w1); st8(rowp + bj * HALF + 16, w2);
                    if (ob) { float* d = ob + ((size_t)(u.pm * 4 + l) * 256 + rin) * 512 + bj * HALF + c; st16f(d, x1); st16f(d + 16, x2); } } }
    }
};
struct InOrder : StaticOrder {
    __device__ __forceinline__ bool next(int i, Unit& u) const {
        if (!StaticOrder::next(i, u)) return false;
        const int q = u.pm / 3, r = u.pm - 3 * q; u.pm = (r == 0) ? q : 16 + 2 * q + r - 1; return true;
    }
};
struct EpiInAll {
    static constexpr bool AFTER_DRAIN = false; static constexpr int NKIND = 3;
    static __device__ __forceinline__ int kind(const Unit& u) { return (u.pn >= 6 && u.pn <= 10) ? 1 : ((u.pn >= 12 && u.pn <= 15) ? 2 : 0); }
    static __device__ __forceinline__ int browk(int kd, int R) { return kd == 0 ? EpiInP::brow(R) : (kd == 1 ? EpiInG::brow(R) : EpiInD::brow(R)); }
    EpiInP p; EpiInG g; EpiInD d;
    __device__ __forceinline__ void operator()(const f32x4 (&acc)[2][2][4][2], const Unit& u, int wr, int wc, int fr, int fq) const {
        const int kd = kind(u);
        if (kd == 0) p(acc, u, wr, wc, fr, fq); else if (kd == 1) g(acc, u, wr, wc, fr, fq); else d(acc, u, wr, wc, fr, fq);
    }
};
template <int KINDS> struct SubOrder : StaticOrder {
    __host__ __device__ bool next(int i, Unit& u) const { if (!StaticOrder::next(i, u)) return false;
        if (KINDS == 0) u.pn = (u.pn < 6) ? u.pn : (u.pn == 6 ? 11 : u.pn + 9); else if (KINDS == 1) u.pn += 6; else u.pn += 12; return true; }
};

template <class Epi, class Sched, bool ALIGN_EPI = false, bool SP2 = false, int MB = 4>
__device__ __forceinline__ void gemm_phase(PG8_LAS unsigned char* lds, const Gemm g, const Sched& S, const Epi& E) {
    int tid_ = threadIdx.x; asm volatile("" : "+v"(tid_)); const int tid = tid_, wid = __builtin_amdgcn_readfirstlane(tid >> 6), lane = tid & 63, wr = wid >> 2, wc = wid & 3, fr = lane & 15, fq = lane >> 4;
    const int K = g.K;
    constexpr int NK = Epi::NKIND;
    unsigned voffA[2], voffBk[NK][2];
#pragma unroll
    for (int i = 0; i < 2; ++i) { int R, C; stage_rc(tid * 16 + i * 8192, R, C);
        const int Ra = (MB == 4) ? R : (R >> 6) * 48 + ((R & 63) < 48 ? (R & 63) : 47); voffA[i] = (unsigned)(Ra * K + C) * 2u;
#pragma unroll
        for (int kd = 0; kd < NK; ++kd) voffBk[kd][i] = (unsigned)(Epi::browk(kd, R) * K + C) * 2u; }
    const size_t kstep = (size_t)(BK * 2);
    const size_t hstepB = (size_t)HALF * K * 2, hstepA = (size_t)(32 * MB) * K * 2;
    const size_t tstepB = 2 * hstepB, tstepA = 2 * hstepA;
    const unsigned ldsw = (unsigned)wid * 1024u;
    const int aoff = lds_byte(wr * 64 + fr, fq * 8), boff = lds_byte(wc * 32 + fr, fq * 8);
#define PG8_SA(b, h) (((b) * 2 + (h)) * HTB)
#define PG8_SB(b, h) ((4 + (b) * 2 + (h)) * HTB)
#define PG8_STAGE(bufoff, gbase, voff) do { _Pragma("unroll") for (int _i = 0; _i < 2; ++_i) \
        __builtin_amdgcn_global_load_lds((const unsigned*)((const char*)(gbase) + (voff)[_i]), (PG8_LAS unsigned*)(lds + (bufoff) + ldsw + _i * 8192), 16, 0, 0); } while (0)
#define PG8_LDA(dst, b, h) do { _Pragma("unroll") for (int m = 0; m < MB; ++m) _Pragma("unroll") for (int k = 0; k < 2; ++k) dst[m][k] = *(const PG8_LAS bf16x8*)(lds + PG8_SA(b, h) + aoff + m * 2048 + k * 1024); } while (0)
#define PG8_LDB(dst, b, h) do { _Pragma("unroll") for (int n = 0; n < 2; ++n) _Pragma("unroll") for (int k = 0; k < 2; ++k) dst[n][k] = *(const PG8_LAS bf16x8*)(lds + PG8_SB(b, h) + boff + n * 2048 + k * 1024); } while (0)
#define PG8_MMA(ai, bj, At, Bt) do { __builtin_amdgcn_s_setprio(1); _Pragma("unroll") for (int m = 0; m < MB; ++m) _Pragma("unroll") for (int n = 0; n < 2; ++n) _Pragma("unroll") for (int k = 0; k < 2; ++k) \
        acc[ai][bj][m][n] = __builtin_amdgcn_mfma_f32_16x16x32_bf16(Bt[n][k], At[m][k], acc[ai][bj][m][n], 0, 0, 0); __builtin_amdgcn_s_setprio(0); } while (0)
#define PG8_WAIT_V(n) asm volatile("s_waitcnt vmcnt(" #n ")" ::: "memory")
#define PG8_WAIT_L(n) asm volatile("s_waitcnt lgkmcnt(" #n ")" ::: "memory")
#define PG8_BAR __builtin_amdgcn_s_barrier()
#define PG8_SCHED __builtin_amdgcn_sched_barrier(0)
    Unit cur, nxt; int ui = 0;
    if (!S.next(0, cur)) return;
    if (!Sched::SPLITK) { cur.k0 = 0; cur.nt = K / BK; }
    unsigned vbc[2], vbn[2];
#define PG8_SELB(dst, un) do { const int kd_ = Epi::kind(un); _Pragma("unroll") for (int i_ = 0; i_ < 2; ++i_) { unsigned v_ = voffBk[0][i_]; _Pragma("unroll") for (int q_ = 1; q_ < NK; ++q_) v_ = (kd_ == q_) ? voffBk[q_][i_] : v_; dst[i_] = v_; } } while (0)
    PG8_SELB(vbc, cur);
    f32x4 acc[2][2][4][2];
#pragma unroll
    for (int a = 0; a < 2; ++a)
#pragma unroll
        for (int b = 0; b < 2; ++b)
#pragma unroll
            for (int m = 0; m < 4; ++m)
#pragma unroll
                for (int n = 0; n < 2; ++n) acc[a][b][m][n] = (f32x4){0.f, 0.f, 0.f, 0.f};
    bf16x8 At[4][2], B0[2][2], B1[2][2];
    const char* cA = (const char*)g.A + (size_t)cur.pm * tstepA + (size_t)cur.k0 * 2; const char* cB = (const char*)g.Bt + (size_t)cur.pn * tstepB + (size_t)cur.k0 * 2;
    S.a_ready(cur);
    if constexpr (SP2) {
        PG8_STAGE(PG8_SB(0, 0), cB, vbc); PG8_STAGE(PG8_SB(0, 1), cB + hstepB, vbc); PG8_STAGE(PG8_SA(0, 0), cA, voffA); PG8_STAGE(PG8_SA(0, 1), cA + hstepA, voffA);
        if (wr == 1) PG8_BAR;
        PG8_WAIT_V(2); PG8_BAR;
        PG8_STAGE(PG8_SB(1, 0), cB + kstep, vbc); PG8_STAGE(PG8_SA(1, 0), cA + kstep, voffA); PG8_STAGE(PG8_SB(1, 1), cB + hstepB + kstep, vbc);
        PG8_WAIT_V(6); PG8_BAR;
    } else {
        PG8_STAGE(PG8_SB(0, 0), cB, vbc); PG8_STAGE(PG8_SA(0, 0), cA, voffA); PG8_STAGE(PG8_SB(0, 1), cB + hstepB, vbc); PG8_STAGE(PG8_SA(0, 1), cA + hstepA, voffA);
        if (wr == 1) PG8_BAR;
        PG8_WAIT_V(4); PG8_BAR;
        PG8_STAGE(PG8_SB(1, 0), cB + kstep, vbc); PG8_STAGE(PG8_SA(1, 0), cA + kstep, voffA); PG8_STAGE(PG8_SB(1, 1), cB + hstepB + kstep, vbc);
        PG8_WAIT_V(6); PG8_BAR;
    }
    for (;;) {
        const bool has_next = S.next(ui + 1, nxt);
        if (!Sched::SPLITK) { nxt.k0 = 0; nxt.nt = K / BK; }
        const int nt = cur.nt;
        if (has_next) PG8_SELB(vbn, nxt); else { vbn[0] = vbc[0]; vbn[1] = vbc[1]; }
        const char* nA = has_next ? (const char*)g.A + (size_t)nxt.pm * tstepA + (size_t)nxt.k0 * 2 : cA; const char* nB = has_next ? (const char*)g.Bt + (size_t)nxt.pn * tstepB + (size_t)nxt.k0 * 2 : cB;
        for (int t = 0; t < nt; t += 2) {
            const bool last = (t == nt - 2);
            unsigned vbl[2]; vbl[0] = last ? vbn[0] : vbc[0]; vbl[1] = last ? vbn[1] : vbc[1];
            const char* a1 = cA + (size_t)(t + 1) * kstep;
            const char* a2 = last ? nA : cA + (size_t)(t + 2) * kstep; const char* b2 = last ? nB : cB + (size_t)(t + 2) * kstep;
            const char* a3 = a2 + kstep; const char* b3 = b2 + kstep;
            if (last && has_next) S.a_ready(nxt);
            if constexpr (SP2) {
            PG8_LDB(B0, 0, 0); PG8_LDB(B1, 0, 1); PG8_SCHED; PG8_LDA(At, 0, 0); PG8_STAGE(PG8_SA(1, 1), a1 + hstepA, voffA);
            PG8_WAIT_V(8); PG8_WAIT_L(0); PG8_BAR; PG8_MMA(0, 0, At, B0); PG8_MMA(0, 1, At, B1); PG8_BAR; PG8_SCHED;
            PG8_LDA(At, 0, 1); PG8_STAGE(PG8_SB(0, 0), b2, vbl); PG8_STAGE(PG8_SB(0, 1), b2 + hstepB, vbl); PG8_STAGE(PG8_SA(0, 0), a2, voffA);
            PG8_WAIT_V(8); PG8_WAIT_L(0); PG8_BAR; PG8_MMA(1, 0, At, B0); PG8_MMA(1, 1, At, B1); PG8_BAR; PG8_SCHED;
            PG8_LDB(B0, 1, 0); PG8_LDB(B1, 1, 1); PG8_SCHED; PG8_LDA(At, 1, 0); PG8_STAGE(PG8_SA(0, 1), a2 + hstepA, voffA);
            PG8_WAIT_V(8); PG8_WAIT_L(0); PG8_BAR; PG8_MMA(0, 0, At, B0); PG8_MMA(0, 1, At, B1); PG8_BAR; PG8_SCHED;
            PG8_LDA(At, 1, 1); PG8_STAGE(PG8_SB(1, 0), b3, vbl); PG8_STAGE(PG8_SB(1, 1), b3 + hstepB, vbl); PG8_STAGE(PG8_SA(1, 0), a3, voffA);
            PG8_WAIT_V(8); PG8_WAIT_L(0); PG8_BAR; PG8_MMA(1, 0, At, B0); PG8_MMA(1, 1, At, B1); PG8_BAR; PG8_SCHED;
            } else {
            PG8_LDB(B0, 0, 0); PG8_SCHED; PG8_LDA(At, 0, 0); PG8_STAGE(PG8_SA(1, 1), a1 + hstepA, voffA);
            PG8_WAIT_L(8); PG8_BAR; PG8_WAIT_L(0); PG8_MMA(0, 0, At, B0); PG8_BAR; PG8_SCHED;
            PG8_LDB(B1, 0, 1); PG8_STAGE(PG8_SB(0, 0), b2, vbl);
            PG8_BAR; PG8_WAIT_L(0); PG8_MMA(0, 1, At, B1); PG8_BAR;
            PG8_LDA(At, 0, 1); PG8_STAGE(PG8_SA(0, 0), a2, voffA);
            PG8_BAR; PG8_WAIT_L(0); PG8_MMA(1, 0, At, B0); PG8_BAR; PG8_SCHED;
            PG8_STAGE(PG8_SB(0, 1), b2 + hstepB, vbl);
            PG8_WAIT_V(6); PG8_BAR; PG8_MMA(1, 1, At, B1); PG8_BAR;
            PG8_LDB(B0, 1, 0); PG8_SCHED; PG8_LDA(At, 1, 0); PG8_STAGE(PG8_SA(0, 1), a2 + hstepA, voffA);
            PG8_WAIT_L(8); PG8_BAR; PG8_WAIT_L(0); PG8_MMA(0, 0, At, B0); PG8_BAR; PG8_SCHED;
            PG8_LDB(B1, 1, 1); PG8_STAGE(PG8_SB(1, 0), b3, vbl);
            PG8_BAR; PG8_WAIT_L(0); PG8_MMA(0, 1, At, B1); PG8_BAR;
            PG8_LDA(At, 1, 1); PG8_STAGE(PG8_SA(1, 0), a3, voffA);
            PG8_BAR; PG8_WAIT_L(0); PG8_MMA(1, 0, At, B0); PG8_BAR; PG8_SCHED;
            PG8_STAGE(PG8_SB(1, 1), b3 + hstepB, vbl);
            PG8_WAIT_V(6); PG8_BAR; PG8_MMA(1, 1, At, B1); PG8_BAR;
            }
        }
        if constexpr (ALIGN_EPI) { if (wr == 0) PG8_BAR; }
        if constexpr (!Epi::AFTER_DRAIN) { E(acc, cur, wr, wc, fr, fq); S.done(cur); }
        if (!has_next) break;
#pragma unroll
        for (int a = 0; a < 2; ++a)
#pragma unroll
            for (int b = 0; b < 2; ++b)
#pragma unroll
                for (int m = 0; m < 4; ++m)
#pragma unroll
                    for (int n = 0; n < 2; ++n) acc[a][b][m][n] = (f32x4){0.f, 0.f, 0.f, 0.f};
        cur = nxt; cA = nA; cB = nB; ++ui; vbc[0] = vbn[0]; vbc[1] = vbn[1];
        if constexpr (ALIGN_EPI) { if (wr == 1) PG8_BAR; }
    }
    PG8_WAIT_V(0);
    if constexpr (!ALIGN_EPI) { if (wr == 0) PG8_BAR; }
    PG8_BAR;
    if constexpr (Epi::AFTER_DRAIN) { E.fused(acc, cur, wr, wc, fr, fq, lds, wid, lane); S.done(cur); }
#undef PG8_SA
#undef PG8_SB
#undef PG8_STAGE
#undef PG8_LDA
#undef PG8_LDB
#undef PG8_MMA
#undef PG8_WAIT_V
#undef PG8_WAIT_L
#undef PG8_BAR
#undef PG8_SCHED
#undef PG8_SELB
}
}

constexpr int DM = 2048, NCTX = 4096, NLAT = 8192, MTOK = 12288, DEPTH = 4, DIN = 4608, DFF = 8192, NMODW = 12288;
constexpr int CTX_B = 16, CTX_T = 256, LAT_B = 8, LAT_T = 1024, PAST = 256;
constexpr int C_NAQ = 0, C_NAK = 512, C_NAV = 1024, C_GQ = 1536, C_GK = 2560, C_GV = 2816, C_DQ = 3072, C_DK = 3584, C_DV = 4096;
constexpr int AO_NA = 0, AO_G = 512, AO_D = 1536;
constexpr float EPS = 1e-6f;
constexpr size_t OUT_X = 0, OUT_NAK = 25165824, OUT_NAV = OUT_NAK + 8388608, OUT_GK = OUT_NAV + 8388608, OUT_GV = OUT_GK + 4194304, OUT_DK = OUT_GV + 4194304, OUT_DV = OUT_DK + 8388608, OUT_END = OUT_DV + 8388608;
static_assert(OUT_END == 67108864, "out map");
constexpr size_t MiB = 1u << 20;
constexpr size_t WS_CTL = 0, CTL_ZERO_BYTES = 20480;
constexpr size_t WS_MOD = 1 * MiB;
constexpr size_t WS_ROPE = 3 * MiB;
constexpr size_t WS_WIN = 4 * MiB;
constexpr size_t WS_WOUT = 76 * MiB;
constexpr size_t WS_WUP = 108 * MiB;
constexpr size_t WS_WDN = 236 * MiB;
constexpr size_t WS_H = 364 * MiB;
constexpr size_t WS_QKV = 412 * MiB;
constexpr size_t WS_AO = WS_H;
constexpr size_t WS_O2 = WS_QKV;
constexpr size_t WS_O2B = WS_QKV + 48 * MiB;
constexpr size_t WS_XB = 928 * MiB;
constexpr size_t WS_U = 664 * MiB;
constexpr size_t WS_CNAK = 856 * MiB, WS_CNAV = 864 * MiB, WS_CGK = 872 * MiB, WS_CGV = 876 * MiB, WS_CDK = 880 * MiB, WS_CDV = 888 * MiB;
constexpr size_t WS_END = 896 * MiB;
constexpr int CW_BAR = 0;

constexpr int RING_OFF = 0, RING_BYTES = 131072;
constexpr int LDSCTL_OFF = RING_BYTES, MISC_OFF = LDSCTL_OFF + 320;
constexpr int LDS_BYTES = 147456;
constexpr int NWAVES = 8, NTHREADS = 512;

#define GAS __attribute__((address_space(1)))
#define LAS __attribute__((address_space(3)))
typedef unsigned short bf16;
typedef unsigned v4u __attribute__((ext_vector_type(4)));
typedef unsigned v2u __attribute__((ext_vector_type(2)));
typedef float f32x4 __attribute__((ext_vector_type(4)));
typedef float f32x2 __attribute__((ext_vector_type(2)));
#define LDS_WAIT() asm volatile("s_waitcnt lgkmcnt(0)" ::: "memory")
#define VM_WAIT() asm volatile("s_waitcnt vmcnt(0)" ::: "memory")
__device__ __forceinline__ unsigned f2bf(float f) { unsigned u = __builtin_bit_cast(unsigned, f); return (u + 0x7fffu + ((u >> 16) & 1u)) >> 16; }
__device__ __forceinline__ unsigned pk2(float lo, float hi) { return f2bf(lo) | (f2bf(hi) << 16); }
__device__ __forceinline__ float bf_lo(unsigned u) { return __builtin_bit_cast(float, u << 16); }
__device__ __forceinline__ float bf_hi(unsigned u) { return __builtin_bit_cast(float, u & 0xffff0000u); }
__device__ __forceinline__ float wave_sum(float v) {
#pragma unroll
    for (int o = 1; o < 64; o <<= 1) v += __shfl_xor(v, o);
    return v;
}
__device__ __forceinline__ float half_sum(float v) {
#pragma unroll
    for (int o = 1; o < 32; o <<= 1) v += __shfl_xor(v, o);
    return v;
}

struct Args { const float* in[22]; float* out; unsigned char* ws; int ph_lo, ph_hi; };
typedef const __attribute__((address_space(4))) Args CArgs;
__device__ __forceinline__ CArgs* args_here() { CArgs* p = (CArgs*)__builtin_amdgcn_kernarg_segment_ptr(); asm volatile("" : "+s"(p)); return p; }
enum { I_XP = 0, I_XS, I_C, I_CNAK, I_CNAV, I_CGK, I_CGV, I_CDK, I_CDV, I_CCTX, I_WADA, I_BADA, I_NORMG, I_WIN, I_WOUT, I_RPB, I_QG, I_KG, I_LAM, I_DG, I_WUP, I_WDN };

#define XB_TMO      128
#define XB_XCNT(j)  (256  + 64 * (j))
#define XB_XSUB(j)  (1280 + 64 * (j))
#define XB_XGEN(j)  (2304 + 64 * (j))
#define XB_TOP      3328
#define XB_TOPGEN   3392
#define XCD_BAR_WORDS 3456
#define XB_SPIN_CAP (1u << 18)

__device__ __forceinline__ unsigned xb_ld(unsigned* p)              { return __hip_atomic_load(p, __ATOMIC_RELAXED, __HIP_MEMORY_SCOPE_AGENT); }
__device__ __forceinline__ unsigned xb_add(unsigned* p, unsigned v) { return __hip_atomic_fetch_add(p, v, __ATOMIC_RELAXED, __HIP_MEMORY_SCOPE_AGENT); }
__device__ __forceinline__ unsigned xb_xcc_id() { return (unsigned)__builtin_amdgcn_s_getreg((3 << 11) | 20) & 0xFu; }
#define XB_SPIN(cond, bar) do { unsigned _sp = 0; while (cond) { __builtin_amdgcn_s_sleep(1); \
    if ((++_sp & 255u) == 0u) { if (xb_ld(&(bar)[XB_TMO])) break; if (_sp > XB_SPIN_CAP) { atomicAdd(&(bar)[XB_TMO], 1u); break; } } } } while (0)

struct XcdBarrier {
    unsigned* bar; unsigned x;
    volatile LAS unsigned* st;
};

__device__ __forceinline__ XcdBarrier xcd_barrier_post(unsigned* bar, volatile LAS unsigned* st) {
    XcdBarrier b; b.bar = bar; b.x = xb_xcc_id(); b.st = st;
    if (threadIdx.x == 0) (void)xb_add(&bar[XB_XCNT(b.x)], 1u);
    return b;
}
__device__ __forceinline__ void xcd_barrier_complete(unsigned* bar, unsigned x, unsigned& nloc, unsigned& nx) {
    const unsigned G = gridDim.x * gridDim.y * gridDim.z;
    unsigned sum, cnt, mine, sp = 0u;
    for (;;) {
        sum = 0u; cnt = 0u; mine = 0u;
#pragma unroll
        for (unsigned j = 0; j < 16; ++j) { const unsigned c = xb_ld(&bar[XB_XCNT(j)]); sum += c; cnt += (c > 0u) ? 1u : 0u; mine = (j == x) ? c : mine; }
        if (sum == G) break;
        __builtin_amdgcn_s_sleep(1);
        if ((++sp & 255u) == 0u) { if (xb_ld(&bar[XB_TMO])) break; if (sp > XB_SPIN_CAP) { atomicAdd(&bar[XB_TMO], 1u); break; } }
    }
    nloc = mine > 0u ? mine : 1u; nx = cnt > 0u ? cnt : 1u;
}

__device__ __forceinline__ void xcd_barrier(const XcdBarrier& b) {
    asm volatile("s_waitcnt vmcnt(0)" ::: "memory");
    __syncthreads();
    if (threadIdx.x == 0) {
        unsigned* bar = b.bar;
        __builtin_amdgcn_s_waitcnt(0);
        unsigned nloc = b.st[0], nx = b.st[1];
        if (nloc == 0u) { xcd_barrier_complete(bar, b.x, nloc, nx); b.st[0] = nloc; b.st[1] = nx; }
        const unsigned old = xb_add(&bar[XB_XSUB(b.x)], 1u);
        const unsigned gen = old / nloc;
        if (old + 1u == (gen + 1u) * nloc) {
            __builtin_amdgcn_fence(__ATOMIC_RELEASE, "agent");
            asm volatile("s_waitcnt vmcnt(0)" ::: "memory");
            const unsigned og = xb_add(&bar[XB_TOP], 1u);
            const unsigned tg = og / nx;
            if (og + 1u == (tg + 1u) * nx) xb_add(&bar[XB_TOPGEN], 1u);
            else XB_SPIN(xb_ld(&bar[XB_TOPGEN]) == tg, bar);
            __builtin_amdgcn_fence(__ATOMIC_ACQUIRE, "agent");
            xb_add(&bar[XB_XGEN(b.x)], 1u);
            asm volatile("s_waitcnt vmcnt(0)" ::: "memory");
        } else {
            XB_SPIN(xb_ld(&bar[XB_XGEN(b.x)]) == gen, bar);
            __builtin_amdgcn_fence(__ATOMIC_ACQUIRE, "agent");
            asm volatile("s_waitcnt vmcnt(0)" ::: "memory");
        }
    }
    __syncthreads();
}
struct Ctx { LAS unsigned char* lds; int tid, lane, wave, vcu, G, gw, NGW; };

constexpr int CV_IN = (DM / 64) * (DIN / 32), CV_OUT = (DM / 64) * (DM / 32), CV_UP = (DM / 64) * (DFF / 32), CV_DN = (DFF / 64) * (DM / 32), CV_PER_L = CV_IN + CV_OUT + CV_UP + CV_DN;
__device__ __forceinline__ void conv_locate(CArgs* a, int it, const float*& Wt, bf16*& WTt, int& K, int& N) {
    unsigned char* ws = a->ws; const int l = it / CV_PER_L; int r = it % CV_PER_L; const float* W; bf16* WT;
    if (r < CV_IN) { W = a->in[I_WIN] + (size_t)l * DM * DIN; WT = (bf16*)(ws + WS_WIN) + (size_t)l * DIN * DM; K = DM; N = DIN; }
    else if (r < CV_IN + CV_OUT) { r -= CV_IN; W = a->in[I_WOUT] + (size_t)l * DM * DM; WT = (bf16*)(ws + WS_WOUT) + (size_t)l * DM * DM; K = DM; N = DM; }
    else if (r < CV_IN + CV_OUT + CV_UP) { r -= CV_IN + CV_OUT; W = a->in[I_WUP] + (size_t)l * DM * DFF; WT = (bf16*)(ws + WS_WUP) + (size_t)l * DFF * DM; K = DM; N = DFF; }
    else { r -= CV_IN + CV_OUT + CV_UP; W = a->in[I_WDN] + (size_t)l * DFF * DM; WT = (bf16*)(ws + WS_WDN) + (size_t)l * DM * DFF; K = DFF; N = DM; }
    const int nblk = N / 32, kb = r / nblk, nb = r - kb * nblk;
    Wt = W + (size_t)(64 * kb) * N + 32 * nb; WTt = WT + (size_t)(32 * nb) * K + 64 * kb;
}
#define CONV_LOAD(Wt, N) do { const float* s_ = (Wt) + (size_t)(lane >> 3) * (N) + 4 * (lane & 7); _Pragma("unroll") for (int i = 0; i < 8; ++i) w[i] = __builtin_nontemporal_load((const f32x4*)(s_ + (size_t)(8 * i) * (N))); } while (0)
__device__ __forceinline__ void conv_all(CArgs* a, LAS float* scr, int it, int step, int lane) {
    constexpr int TOT = DEPTH * CV_PER_L;
    f32x4 w[8]; const float* Wt; bf16* WTt; int K, N;
    if (it < TOT) { conv_locate(a, it, Wt, WTt, K, N); CONV_LOAD(Wt, N); }
    while (it < TOT) {
        { LAS float* d = scr + (lane >> 3) * 33 + 4 * (lane & 7);
#pragma unroll
          for (int i = 0; i < 8; ++i) { d[i * 8 * 33 + 0] = w[i].x; d[i * 8 * 33 + 1] = w[i].y; d[i * 8 * 33 + 2] = w[i].z; d[i * 8 * 33 + 3] = w[i].w; } }
        bf16* const WTc = WTt; const int Kc = K;
        it += step;
        if (it < TOT) { conv_locate(a, it, Wt, WTt, K, N); CONV_LOAD(Wt, N); }
        asm volatile("" ::: "memory");
        const int c = lane & 7;
#pragma unroll
        for (int j = 0; j < 4; ++j) { const int n = (lane >> 3) + 8 * j; const LAS float* s = scr + (8 * c) * 33 + n;
            v4u o; o.x = pk2(s[0 * 33], s[1 * 33]); o.y = pk2(s[2 * 33], s[3 * 33]); o.z = pk2(s[4 * 33], s[5 * 33]); o.w = pk2(s[6 * 33], s[7 * 33]);
            *(GAS v4u*)(WTc + (size_t)n * Kc + 8 * c) = o; }
        LDS_WAIT(); asm volatile("" ::: "memory");
    }
}

__device__ __forceinline__ void cvt_tensor(const float* src, bf16* dst, size_t n8, size_t gt, size_t NT) {
    for (size_t i = gt; i < n8; i += 4 * NT) { f32x4 a[4], b[4];
#pragma unroll
        for (int u = 0; u < 4; ++u) if (i + u * NT < n8) { a[u] = __builtin_nontemporal_load((const f32x4*)(src + (i + u * NT) * 8)); b[u] = __builtin_nontemporal_load((const f32x4*)(src + (i + u * NT) * 8 + 4)); }
#pragma unroll
        for (int u = 0; u < 4; ++u) if (i + u * NT < n8) { v4u o; o.x = pk2(a[u].x, a[u].y); o.y = pk2(a[u].z, a[u].w); o.z = pk2(b[u].x, b[u].y); o.w = pk2(b[u].z, b[u].w); *(v4u*)(dst + (i + u * NT) * 8) = o; } }
}

__device__ __forceinline__ void ph_prologue(CArgs* a, const Ctx& X) {
    unsigned char* ws = a->ws;
#ifndef PROMASK
#define PROMASK 15
#endif
    if (PROMASK & 1)
    {
        constexpr int SLW = 2176;
        LAS float* sl = (LAS float*)X.lds; LAS float* red = (LAS float*)(X.lds + 9 * SLW * 4);
        const float* cin = a->in[I_C]; const float* cctx = a->in[I_CCTX];
        for (int i = X.tid; i < 9 * 2048; i += NTHREADS) { const int v = i >> 11, k = i & 2047; const float x = (v < 8) ? cin[v * 2048 + k] : cctx[k];
            sl[v * SLW + k + 4 * (k >> 6)] = x / (1.0f + expf(-x)); }
        __syncthreads();
        float* mod = (float*)(ws + WS_MOD); const float* wada = a->in[I_WADA]; const float* bada = a->in[I_BADA];
        const int kq = X.tid >> 4, cg = X.tid & 15, k0 = kq * 64;
        for (int item = X.vcu; item < DEPTH * 192; item += X.G) {
            const int l = item / 192, n0 = (item % 192) * 64;
            const float* W = wada + (size_t)l * DM * NMODW + n0 + 4 * cg;
            f32x4 acc[9];
#pragma unroll
            for (int v = 0; v < 9; ++v) acc[v] = (f32x4){0.f, 0.f, 0.f, 0.f};
            const float* Wp = W + (size_t)k0 * NMODW;
#pragma unroll 1
            for (int kk = 0; kk < 64; kk += 8) {
                f32x4 w[8];
#pragma unroll
                for (int i = 0; i < 8; ++i) w[i] = __builtin_nontemporal_load((const f32x4*)(Wp + (size_t)i * NMODW));
                Wp += (size_t)8 * NMODW;
#pragma unroll
                for (int v = 0; v < 9; ++v) { const f32x4 s0 = *(const LAS f32x4*)(sl + v * SLW + k0 + kk + 4 * kq), s1 = *(const LAS f32x4*)(sl + v * SLW + k0 + kk + 4 + 4 * kq);
                    acc[v] += w[0] * s0.x + w[1] * s0.y + w[2] * s0.z + w[3] * s0.w + w[4] * s1.x + w[5] * s1.y + w[6] * s1.z + w[7] * s1.w; }
            }
#pragma unroll
            for (int v = 0; v < 9; ++v)
#pragma unroll
                for (int j = 0; j < 4; ++j) { float t = acc[v][j]; t += __shfl_xor(t, 16); t += __shfl_xor(t, 32); acc[v][j] = t; }
            if (X.lane < 16) {
#pragma unroll
                for (int v = 0; v < 9; ++v) *(LAS f32x4*)(red + (X.wave * 9 + v) * 64 + 4 * X.lane) = acc[v];
            }
            __syncthreads();
            for (int o = X.tid; o < 576; o += NTHREADS) { const int v = o >> 6, cc = o & 63; float s = 0.f;
#pragma unroll
                for (int w = 0; w < 8; ++w) s += red[(w * 9 + v) * 64 + cc];
                mod[(size_t)(l * 9 + v) * NMODW + n0 + cc] = s + bada[l * NMODW + n0 + cc]; }
            __syncthreads();
        }
    }
    if (PROMASK & 2)
    if (PROMASK & 2)
    {
        LAS float* scr = (LAS float*)(X.lds + RING_OFF + X.wave * 16384);
        conv_all(a, scr, X.gw, X.NGW, X.lane);
    }
    if (PROMASK & 4)
    {
        f32x2* rope = (f32x2*)(ws + WS_ROPE);
        for (int i = X.vcu * NTHREADS + X.tid; i < 64 * 48; i += X.G * NTHREADS) { const int pos = i / 48, f = i % 48;
            const double e = (f < 32) ? (double)f / 32.0 : (double)(f - 32) / 16.0;
            const float inv = (float)exp(-9.210340371976184 * e); const float ang = (float)pos * inv;
            const double ad = (double)ang; const double nq = __builtin_rint(ad * 0.6366197723675814); const double r = ad - nq * 1.5707963267948966, r2 = r * r;
            const double sr = r * (1.0 + r2 * (-1.0 / 6 + r2 * (1.0 / 120 + r2 * (-1.0 / 5040 + r2 * (1.0 / 362880 + r2 * (-1.0 / 39916800 + r2 * (1.0 / 6227020800.0)))))));
            const double cr = 1.0 + r2 * (-0.5 + r2 * (1.0 / 24 + r2 * (-1.0 / 720 + r2 * (1.0 / 40320 + r2 * (-1.0 / 3628800 + r2 * (1.0 / 479001600 + r2 * (-1.0 / 87178291200.0)))))));
            const int q = ((int)nq) & 3;
            const double cv = (q == 0) ? cr : (q == 1) ? -sr : (q == 2) ? -cr : sr, sv = (q == 0) ? sr : (q == 1) ? cr : (q == 2) ? -sr : -cr;
            rope[i] = (f32x2){(float)cv, (float)sv}; }
    }
    if (PROMASK & 8)
    {
        const size_t gt = (size_t)X.vcu * NTHREADS + X.tid, NT = (size_t)X.G * NTHREADS;
        cvt_tensor(a->in[I_CNAK], (bf16*)(ws + WS_CNAK), (size_t)LAT_B * DEPTH * PAST * 512 / 8, gt, NT);
        cvt_tensor(a->in[I_CNAV], (bf16*)(ws + WS_CNAV), (size_t)LAT_B * DEPTH * PAST * 512 / 8, gt, NT);
        cvt_tensor(a->in[I_CGK], (bf16*)(ws + WS_CGK), (size_t)LAT_B * DEPTH * PAST * 256 / 8, gt, NT);
        cvt_tensor(a->in[I_CGV], (bf16*)(ws + WS_CGV), (size_t)LAT_B * DEPTH * PAST * 256 / 8, gt, NT);
        cvt_tensor(a->in[I_CDK], (bf16*)(ws + WS_CDK), (size_t)LAT_B * DEPTH * PAST * 512 / 8, gt, NT);
        cvt_tensor(a->in[I_CDV], (bf16*)(ws + WS_CDV), (size_t)LAT_B * DEPTH * PAST * 512 / 8, gt, NT);
    }
}

__device__ __forceinline__ int mod_vec(int m) { return m < NCTX ? 8 : ((m - NCTX) >> 10); }

__device__ __forceinline__ f32x4 ld_bf4(const bf16* p) { const v2u w = *(const v2u*)p; return (f32x4){bf_lo(w.x), bf_hi(w.x), bf_lo(w.y), bf_hi(w.y)}; }
__device__ __forceinline__ float sumsq4(f32x4 v) { return (v.x * v.x + v.y * v.y) + (v.z * v.z + v.w * v.w); }
template <bool FIRST, bool LAST>
__device__ __forceinline__ void norm_rows(CArgs* a, const Ctx& X, const bf16* o2, const float* g_post, const float* mod_gate, int gate_off,
                                          const float* g_pre, const float* mod_next, int sh_off, int sc_off) {
    bf16* XB = (bf16*)(a->ws + WS_XB); bf16* H = (bf16*)(a->ws + WS_H); const bf16* O2B = (const bf16*)(a->ws + WS_O2B);
    const int lc = 4 * X.lane;
    const int chunk = (MTOK + X.NGW - 1) / X.NGW, mbeg = X.gw * chunk, mend = (mbeg + chunk < MTOK) ? mbeg + chunk : MTOK;
    LAS f32x4* prm = (LAS f32x4*)X.lds;
    const int bfirst = X.vcu * NWAVES * chunk, blast = (bfirst + NWAVES * chunk - 1 < MTOK - 1) ? bfirst + NWAVES * chunk - 1 : MTOK - 1;
    const int mvA = mod_vec(bfirst < MTOK ? bfirst : MTOK - 1), mvB = mod_vec(blast);
    for (int i = X.tid; i < 1024; i += NTHREADS) { const int st = i >> 9, c4 = i & 511, col = 4 * c4, mv = st ? mvB : mvA;
        if (!FIRST) prm[(st * 3 + 0) * 512 + c4] = *(const f32x4*)(g_post + col) * *(const f32x4*)(mod_gate + (size_t)mv * NMODW + gate_off + col);
        if (!LAST) { prm[(st * 3 + 1) * 512 + c4] = *(const f32x4*)(g_pre + col) * (*(const f32x4*)(mod_next + (size_t)mv * NMODW + sc_off + col) + 1.0f);
                     prm[(st * 3 + 2) * 512 + c4] = *(const f32x4*)(mod_next + (size_t)mv * NMODW + sh_off + col); } }
    __syncthreads();
    f32x4 nxf[FIRST ? 8 : 1]; v2u nx[FIRST ? 1 : 8], no[FIRST ? 1 : 8], nb[FIRST ? 1 : 8];
#define NORM_LOAD_ROW(mm) do { const int m_ = (mm); \
        if (FIRST) { const float* src_ = (m_ < NCTX) ? a->in[I_XP] + (size_t)m_ * DM : a->in[I_XS] + (size_t)(m_ - NCTX) * DM; \
            _Pragma("unroll") for (int j = 0; j < 8; ++j) nxf[FIRST ? j : 0] = *(const f32x4*)(src_ + lc + 256 * j); } \
        else { _Pragma("unroll") for (int j = 0; j < 8; ++j) { nx[FIRST ? 0 : j] = *(const v2u*)(XB + (size_t)m_ * DM + lc + 256 * j); no[FIRST ? 0 : j] = *(const v2u*)(o2 + (size_t)m_ * DM + lc + 256 * j); } \
            if (m_ >= 8192) { _Pragma("unroll") for (int j = 0; j < 8; ++j) nb[FIRST ? 0 : j] = *(const v2u*)(O2B + (size_t)(m_ - 8192) * DM + lc + 256 * j); } } } while (0)
#define BF4(w) ((f32x4){bf_lo((w).x), bf_hi((w).x), bf_lo((w).y), bf_hi((w).y)})
    if (mbeg < mend) NORM_LOAD_ROW(mbeg);
    for (int m = mbeg; m < mend; ++m) {
        const LAS f32x4* ps = prm + ((mod_vec(m) == mvA) ? 0 : 3 * 512) + X.lane;
        f32x4 x[8]; f32x4 o[FIRST ? 1 : 8];
        if (FIRST) {
#pragma unroll
            for (int j = 0; j < 8; ++j) x[j] = nxf[FIRST ? j : 0];
        } else {
#pragma unroll
            for (int j = 0; j < 8; ++j) { x[j] = BF4(nx[FIRST ? 0 : j]); o[FIRST ? 0 : j] = BF4(no[FIRST ? 0 : j]); }
            if (m >= 8192) {
#pragma unroll
                for (int j = 0; j < 8; ++j) o[FIRST ? 0 : j] += BF4(nb[FIRST ? 0 : j]); }
        }
        if (m + 1 < mend) NORM_LOAD_ROW(m + 1);
        if (!FIRST) {
            float ss = 0.f;
#pragma unroll
            for (int j = 0; j < 8; ++j) ss += sumsq4(o[FIRST ? 0 : j]);
            const float r1 = 1.0f / sqrtf(wave_sum(ss) * (1.0f / DM) + EPS);
#pragma unroll
            for (int j = 0; j < 8; ++j) x[j] = x[j] + (o[FIRST ? 0 : j] * r1) * ps[0 * 512 + 64 * j];
        }
        if (LAST) {
#pragma unroll
            for (int j = 0; j < 8; ++j) __builtin_nontemporal_store(x[j], (f32x4*)(a->out + (size_t)m * DM + lc + 256 * j));
        } else {
            float ss = 0.f;
#pragma unroll
            for (int j = 0; j < 8; ++j) { ss += sumsq4(x[j]); v2u w; w.x = pk2(x[j].x, x[j].y); w.y = pk2(x[j].z, x[j].w); *(v2u*)(XB + (size_t)m * DM + lc + 256 * j) = w; }
            const float r2 = 1.0f / sqrtf(wave_sum(ss) * (1.0f / DM) + EPS);
#pragma unroll
            for (int j = 0; j < 8; ++j) { const f32x4 h = (x[j] * r2) * ps[1 * 512 + 64 * j] + ps[2 * 512 + 64 * j];
                v2u w; w.x = pk2(h.x, h.y); w.y = pk2(h.z, h.w); *(v2u*)(H + (size_t)m * DM + lc + 256 * j) = w; }
        }
    }
    __syncthreads();
}
#undef NORM_LOAD_ROW
#undef BF4
__device__ __forceinline__ void ph_fixup(CArgs* a, const Ctx& X, int l) {
    bf16* QKV = (bf16*)(a->ws + WS_QKV); const f32x2* rope = (const f32x2*)(a->ws + WS_ROPE);
    const int lane = X.lane;
    const float qg0 = a->in[I_QG][l * 128 + 2 * lane], qg1 = a->in[I_QG][l * 128 + 2 * lane + 1];
    const float kg0 = a->in[I_KG][l * 128 + 2 * lane], kg1 = a->in[I_KG][l * 128 + 2 * lane + 1];
    float* out = a->out;
    for (int m = X.gw; m < MTOK; m += X.NGW) {
        bf16* row = QKV + (size_t)m * DIN + 2 * lane;
        const bool lat = m >= NCTX; const int t = (m - NCTX) & 1023, prow = t >> 6, pcol = t & 63;
        const int cb = m >> 8, ct = m & 255;
        unsigned ug[10];
#pragma unroll
        for (int hh = 0; hh < 10; ++hh) ug[hh] = *(const unsigned*)(row + (hh < 8 ? C_GQ + hh * 128 : C_GK + (hh - 8) * 128));
        if (lat) {
            unsigned ud[8];
#pragma unroll
            for (int hh = 0; hh < 8; ++hh) ud[hh] = *(const unsigned*)(row + (hh < 4 ? C_DQ + hh * 128 : C_DK + (hh - 4) * 128));
            const int posg = (lane < 32) ? prow : pcol, fig = (2 * lane) & 31; const f32x2 g0 = rope[posg * 48 + fig], g1 = rope[posg * 48 + fig + 1]; const float sgg = (lane & 16) ? 1.0f : -1.0f;
            const int posd = (lane & 16) ? pcol : prow, fid = 32 + ((2 * lane) & 15); const f32x2 d0 = rope[posd * 48 + fid], d1 = rope[posd * 48 + fid + 1]; const float sgd = (lane & 8) ? 1.0f : -1.0f;
            float ss[10];
#pragma unroll
            for (int hh = 0; hh < 10; ++hh) { const float x0 = bf_lo(ug[hh]), x1 = bf_hi(ug[hh]); ss[hh] = x0 * x0 + x1 * x1; }
#pragma unroll
            for (int o = 1; o < 64; o <<= 1)
#pragma unroll
                for (int hh = 0; hh < 10; ++hh) ss[hh] += __shfl_xor(ss[hh], o);
#pragma unroll
            for (int hh = 0; hh < 10; ++hh) { const float r = 1.0f / sqrtf(ss[hh] * (1.0f / 128.0f) + EPS);
                float x0 = bf_lo(ug[hh]) * r * (hh < 8 ? qg0 : kg0), x1 = bf_hi(ug[hh]) * r * (hh < 8 ? qg1 : kg1);
                const float p0 = __shfl_xor(x0, 16), p1 = __shfl_xor(x1, 16);
                x0 = x0 * g0.x + sgg * p0 * g0.y; x1 = x1 * g1.x + sgg * p1 * g1.y;
                *(unsigned*)(row + (hh < 8 ? C_GQ + hh * 128 : C_GK + (hh - 8) * 128)) = pk2(x0, x1); }
#pragma unroll
            for (int hh = 0; hh < 8; ++hh) { float x0 = bf_lo(ud[hh]), x1 = bf_hi(ud[hh]);
                const float p0 = __shfl_xor(x0, 8), p1 = __shfl_xor(x1, 8);
                x0 = x0 * d0.x + sgd * p0 * d0.y; x1 = x1 * d1.x + sgd * p1 * d1.y;
                *(unsigned*)(row + (hh < 4 ? C_DQ + hh * 128 : C_DK + (hh - 4) * 128)) = pk2(x0, x1); }
        } else {
            unsigned un[18];
#pragma unroll
            for (int j = 0; j < 4; ++j) { un[j] = *(const unsigned*)(row + C_NAK + j * 128); un[4 + j] = *(const unsigned*)(row + C_NAV + j * 128); un[8 + j] = *(const unsigned*)(row + C_DK + j * 128); un[12 + j] = *(const unsigned*)(row + C_DV + j * 128); }
            un[16] = *(const unsigned*)(row + C_GV); un[17] = *(const unsigned*)(row + C_GV + 128);
            float ss[10];
#pragma unroll
            for (int hh = 0; hh < 10; ++hh) { const float x0 = bf_lo(ug[hh]), x1 = bf_hi(ug[hh]); ss[hh] = x0 * x0 + x1 * x1; }
#pragma unroll
            for (int o = 1; o < 64; o <<= 1)
#pragma unroll
                for (int hh = 0; hh < 10; ++hh) ss[hh] += __shfl_xor(ss[hh], o);
            const size_t r5 = ((size_t)(cb * DEPTH + l) * CTX_T + ct) * 512 + 2 * lane, r2 = ((size_t)(cb * DEPTH + l) * CTX_T + ct) * 256 + 2 * lane;
#pragma unroll
            for (int hh = 0; hh < 10; ++hh) { const float r = 1.0f / sqrtf(ss[hh] * (1.0f / 128.0f) + EPS);
                const float x0 = bf_lo(ug[hh]) * r * (hh < 8 ? qg0 : kg0), x1 = bf_hi(ug[hh]) * r * (hh < 8 ? qg1 : kg1);
                *(unsigned*)(row + (hh < 8 ? C_GQ + hh * 128 : C_GK + (hh - 8) * 128)) = pk2(x0, x1);
                if (hh >= 8) *(f32x2*)(out + OUT_GK + r2 + (hh - 8) * 128) = (f32x2){x0, x1}; }
#pragma unroll
            for (int j = 0; j < 4; ++j) {
                *(f32x2*)(out + OUT_NAK + r5 + j * 128) = (f32x2){bf_lo(un[j]), bf_hi(un[j])};
                *(f32x2*)(out + OUT_NAV + r5 + j * 128) = (f32x2){bf_lo(un[4 + j]), bf_hi(un[4 + j])};
                *(f32x2*)(out + OUT_DK + r5 + j * 128) = (f32x2){bf_lo(un[8 + j]), bf_hi(un[8 + j])};
                *(f32x2*)(out + OUT_DV + r5 + j * 128) = (f32x2){bf_lo(un[12 + j]), bf_hi(un[12 + j])}; }
            *(f32x2*)(out + OUT_GV + r2) = (f32x2){bf_lo(un[16]), bf_hi(un[16])}; *(f32x2*)(out + OUT_GV + r2 + 128) = (f32x2){bf_lo(un[17]), bf_hi(un[17])};
        }
    }
}

__device__ __forceinline__ float lambda_init_of(int l) { return 0.8f - 0.6f * expf(-0.3f * (float)l); }

struct SmState { float m, l, o0, o1; };
__device__ __forceinline__ void sm_step(SmState& S, float s, float v0, float v1) {
    const float mn = fmaxf(S.m, s), al = __expf(S.m - mn), p = __expf(s - mn);
    S.l = S.l * al + p; S.o0 = S.o0 * al + p * v0; S.o1 = S.o1 * al + p * v1; S.m = mn;
}
__device__ __forceinline__ void ph_attn_naive(CArgs* a, const Ctx& X, int l) {
    const bf16* QKV = (const bf16*)(a->ws + WS_QKV); bf16* AO = (bf16*)(a->ws + WS_AO);
    const int lane = X.lane;
    const float li = lambda_init_of(l);
    const float* lamv = a->in[I_LAM] + l * 256;
    const float lam = expf(wave_sum(lamv[lane] * lamv[64 + lane])) - expf(wave_sum(lamv[128 + lane] * lamv[192 + lane])) + li;
    const float dg0 = a->in[I_DG][l * 128 + 2 * lane], dg1 = a->in[I_DG][l * 128 + 2 * lane + 1];
    for (int item = X.gw; item < MTOK * 16; item += X.NGW) {
        const int m = item >> 4, hu = item & 15; const bool lat = m >= NCTX;
        const bf16* qrow = QKV + (size_t)m * DIN;
        if (hu < 12) {
            int qc, kc, vc, ocol, cw, ch; const bf16 *ck, *cv;
            if (hu < 4) { qc = C_NAQ + hu * 128; kc = C_NAK + hu * 128; vc = C_NAV + hu * 128; ocol = AO_NA + hu * 128; cw = 512; ch = hu; ck = (const bf16*)(a->ws + WS_CNAK); cv = (const bf16*)(a->ws + WS_CNAV); }
            else { const int hq = hu - 4, kvh = hq >> 2; qc = C_GQ + hq * 128; kc = C_GK + kvh * 128; vc = C_GV + kvh * 128; ocol = AO_G + hq * 128; cw = 256; ch = kvh; ck = (const bf16*)(a->ws + WS_CGK); cv = (const bf16*)(a->ws + WS_CGV); }
            const unsigned uq = *(const unsigned*)(qrow + qc + 2 * lane); const float q0 = bf_lo(uq), q1 = bf_hi(uq);
            const float scale = 0.08838834764831845f;
            SmState S{-1e30f, 0.f, 0.f, 0.f};
            if (!lat) { const int b = m >> 8;
                for (int s = 0; s < CTX_T; ++s) { const bf16* kr = QKV + (size_t)(b * CTX_T + s) * DIN;
                    const unsigned uk = *(const unsigned*)(kr + kc + 2 * lane), uv = *(const unsigned*)(kr + vc + 2 * lane);
                    const float sc = wave_sum(q0 * bf_lo(uk) + q1 * bf_hi(uk)) * scale; sm_step(S, sc, bf_lo(uv), bf_hi(uv)); }
            } else { const int b = (m - NCTX) >> 10, t = (m - NCTX) & 1023;
                if (hu < 4) { const int rq = t >> 6, cq = t & 63; const int r0 = min(max(rq - 4, 0), 8), w0 = min(max(cq - 8, 0), 48);
                    const float* rpb = a->in[I_RPB] + (size_t)(l * 4 + hu) * 15 * 31;
                    for (int rk = r0; rk < r0 + 8; ++rk) for (int ckk = w0; ckk < w0 + 16; ++ckk) {
                        const bf16* kr = QKV + (size_t)(NCTX + b * LAT_T + rk * 64 + ckk) * DIN;
                        const unsigned uk = *(const unsigned*)(kr + kc + 2 * lane), uv = *(const unsigned*)(kr + vc + 2 * lane);
                        const float sc = wave_sum(q0 * bf_lo(uk) + q1 * bf_hi(uk)) * scale + rpb[(rk - rq + 7) * 31 + (ckk - cq + 15)]; sm_step(S, sc, bf_lo(uv), bf_hi(uv)); }
                } else {
                    for (int s = 0; s < LAT_T; ++s) { const bf16* kr = QKV + (size_t)(NCTX + b * LAT_T + s) * DIN;
                        const unsigned uk = *(const unsigned*)(kr + kc + 2 * lane), uv = *(const unsigned*)(kr + vc + 2 * lane);
                        const float sc = wave_sum(q0 * bf_lo(uk) + q1 * bf_hi(uk)) * scale; sm_step(S, sc, bf_lo(uv), bf_hi(uv)); }
                }
                for (int s = 0; s < PAST; ++s) { const size_t off = ((size_t)(b * DEPTH + l) * PAST + s) * cw + ch * 128 + 2 * lane;
                    const unsigned uk = *(const unsigned*)(ck + off), uv = *(const unsigned*)(cv + off);
                    const float sc = wave_sum(q0 * bf_lo(uk) + q1 * bf_hi(uk)) * scale; sm_step(S, sc, bf_lo(uv), bf_hi(uv)); }
            }
            const float inv = 1.0f / S.l;
            *(unsigned*)(AO + (size_t)m * DM + ocol + 2 * lane) = pk2(S.o0 * inv, S.o1 * inv);
        } else {
            const int h = hu - 12, qc = C_DQ + h * 128, kc = C_DK + h * 128, vc = C_DV + h * 128;
            const unsigned uq = *(const unsigned*)(qrow + qc + 2 * lane); const float q0 = bf_lo(uq), q1 = bf_hi(uq);
            const float scale = 0.125f;
            float mm = -1e30f, ll = 0.f;
            float a0 = 0.f, a1 = 0.f, b0 = 0.f, b1 = 0.f;
#define DIFF_STEP(uk, uv) do { const float sc = half_sum(q0 * bf_lo(uk) + q1 * bf_hi(uk)) * scale; const float mn = fmaxf(mm, sc), al = __expf(mm - mn), p = __expf(sc - mn); \
            ll = ll * al + p; mm = mn; const float al0 = __shfl(al, 0), al1 = __shfl(al, 32), p0 = __shfl(p, 0), p1 = __shfl(p, 32); const float v0 = bf_lo(uv), v1 = bf_hi(uv); \
            a0 = a0 * al0 + p0 * v0; a1 = a1 * al0 + p0 * v1; b0 = b0 * al1 + p1 * v0; b1 = b1 * al1 + p1 * v1; } while (0)
            if (!lat) { const int b = m >> 8;
                for (int s = 0; s < CTX_T; ++s) { const bf16* kr = QKV + (size_t)(b * CTX_T + s) * DIN;
                    const unsigned uk = *(const unsigned*)(kr + kc + 2 * lane), uv = *(const unsigned*)(kr + vc + 2 * lane); DIFF_STEP(uk, uv); }
            } else { const int b = (m - NCTX) >> 10;
                for (int s = 0; s < LAT_T; ++s) { const bf16* kr = QKV + (size_t)(NCTX + b * LAT_T + s) * DIN;
                    const unsigned uk = *(const unsigned*)(kr + kc + 2 * lane), uv = *(const unsigned*)(kr + vc + 2 * lane); DIFF_STEP(uk, uv); }
                const bf16* ck = (const bf16*)(a->ws + WS_CDK); const bf16* cv = (const bf16*)(a->ws + WS_CDV);
                for (int s = 0; s < PAST; ++s) { const size_t off = ((size_t)(b * DEPTH + l) * PAST + s) * 512 + h * 128 + 2 * lane;
                    const unsigned uk = *(const unsigned*)(ck + off), uv = *(const unsigned*)(cv + off); DIFF_STEP(uk, uv); }
            }
#undef DIFF_STEP
            const float l0 = __shfl(ll, 0), l1 = __shfl(ll, 32);
            float o0 = a0 / l0 - lam * (b0 / l1), o1 = a1 / l0 - lam * (b1 / l1);
            const float r = 1.0f / sqrtf(wave_sum(o0 * o0 + o1 * o1) * (1.0f / 128.0f) + EPS);
            o0 = o0 * r * dg0 * (1.0f - li); o1 = o1 * r * dg1 * (1.0f - li);
            *(unsigned*)(AO + (size_t)m * DM + AO_D + h * 128 + 2 * lane) = pk2(o0, o1);
        }
    }
}

namespace att {
using bf16x8 = __attribute__((ext_vector_type(8))) short;
using s16x4  = __attribute__((ext_vector_type(4))) short;
using f32x16 = __attribute__((ext_vector_type(16))) float;
constexpr int QBLK = 32, KVBLK = 64, NW = 8;
constexpr int SHM_V = KVBLK * 128 * 2, SHM_K = KVBLK * 128 * 2;
constexpr int OFF_WS = 2 * SHM_V + 2 * SHM_K, OFF_BT = OFF_WS + NW * 64 * 4, OFF_Q = OFF_BT + 576 * 4, ATT_LDS = OFF_Q + 64;
constexpr float THR = 8.f;
#define KSWZ(row, colB) ((row) * 256 + ((colB) ^ (((row) & 15) << 4)))
#define SBAR() __builtin_amdgcn_sched_barrier(0)
__device__ __forceinline__ int crow(int r, int hi) { return (r & 3) + 8 * (r >> 2) + 4 * hi; }
__device__ __forceinline__ unsigned cvtpk(float lo, float hi) { unsigned r; asm volatile("v_cvt_pk_bf16_f32 %0, %1, %2" : "=v"(r) : "v"(lo), "v"(hi)); return r; }

template <int KIND> struct Sc { static constexpr float SCALE = (KIND == 2) ? 0.125f : 0.08838834764831845f; };

template <int KIND>
__device__ __forceinline__ void partialSM(f32x16& p0, f32x16& p1, float& m_reg, float& mn, float& alpha) {
  constexpr float SCALE = Sc<KIND>::SCALE, C = SCALE * 1.4426950408889634f;
  float pmax = p0[0];
#pragma unroll
  for (int r = 1; r < 16; ++r) pmax = fmaxf(pmax, p0[r]);
#pragma unroll
  for (int r = 0; r < 16; ++r) pmax = fmaxf(pmax, p1[r]);
  { auto rr = __builtin_amdgcn_permlane32_swap(__float_as_uint(pmax), __float_as_uint(pmax), false, false);
    pmax = fmaxf(__uint_as_float(rr[0]), __uint_as_float(rr[1])); }
  if (__builtin_expect(__all(pmax - m_reg <= THR / SCALE), 1)) { mn = m_reg; alpha = 1.f; }
  else { mn = fmaxf(m_reg, pmax); alpha = __builtin_amdgcn_exp2f((m_reg - mn) * C); m_reg = mn; }
  float mnC = -mn * C;
#pragma unroll
  for (int r = 0; r < 16; ++r) p0[r] = fmaf(p0[r], C, mnC);
#pragma unroll
  for (int r = 0; r < 16; ++r) p1[r] = fmaf(p1[r], C, mnC);
#pragma unroll
  for (int r = 0; r < 16; ++r) p0[r] = __builtin_amdgcn_exp2f(p0[r]);
}
__device__ __forceinline__ void finishSM(f32x16& p0, f32x16& p1, float alpha, float& l_reg, bf16x8& pa0, bf16x8& pa1, bf16x8& pa2, bf16x8& pa3) {
#pragma unroll
  for (int r = 0; r < 16; ++r) p1[r] = __builtin_amdgcn_exp2f(p1[r]);
  float ps = 0;
#pragma unroll
  for (int r = 0; r < 16; ++r) ps += p0[r];
#pragma unroll
  for (int r = 0; r < 16; ++r) ps += p1[r];
  { auto rr = __builtin_amdgcn_permlane32_swap(__float_as_uint(ps), __float_as_uint(ps), false, false);
    ps = __uint_as_float(rr[0]) + __uint_as_float(rr[1]); }
  l_reg = l_reg * alpha + ps;
#define PK4(P, BASE, OUT) do { unsigned a0 = cvtpk(P[BASE + 0], P[BASE + 1]), a1 = cvtpk(P[BASE + 2], P[BASE + 3]);   \
    unsigned b0 = cvtpk(P[BASE + 4], P[BASE + 5]), b1 = cvtpk(P[BASE + 6], P[BASE + 7]);                              \
    auto r0 = __builtin_amdgcn_permlane32_swap(a0, b0, false, false); auto r1 = __builtin_amdgcn_permlane32_swap(a1, b1, false, false); \
    v4u w = {r0[0], r1[0], r0[1], r1[1]}; OUT = __builtin_bit_cast(bf16x8, w); } while (0)
  PK4(p0, 0, pa0); PK4(p0, 8, pa1); PK4(p1, 0, pa2); PK4(p1, 8, pa3);
#undef PK4
}
template <int ND0>
__device__ __forceinline__ void qkt(f32x16& p0, f32x16& p1, const LAS char* Ks, const bf16x8* qr, int r32, int hi, int dbase) {
  p0 = f32x16{}; p1 = f32x16{};
#pragma unroll
  for (int d0 = 0; d0 < ND0; ++d0) { const int cb = (dbase + d0 * 16 + hi * 8) * 2;
    const bf16x8 b0 = *(const LAS bf16x8*)(Ks + KSWZ(r32, cb));
    const bf16x8 b1 = *(const LAS bf16x8*)(Ks + KSWZ(32 + r32, cb));
    p0 = __builtin_amdgcn_mfma_f32_32x32x16_bf16(b0, qr[d0], p0, 0, 0, 0);
    p1 = __builtin_amdgcn_mfma_f32_32x32x16_bf16(b1, qr[d0], p1, 0, 0, 0); }
}
__device__ __forceinline__ int v_st(int k, int c) { const int kk = (k & ~0xC) | ((k & 4) << 1) | ((k & 8) >> 1); return ((kk >> 3) * 4 + (c >> 5)) * 512 + ((kk & 7) * 32 + (c & 31)) * 2; }
__device__ __forceinline__ int v_rd_base(int lane) { return ((lane & 3) << 3) | (((lane >> 2) & 3) << 6) | (((lane >> 4) & 1) << 5) | (((lane >> 5) & 1) << 8); }
constexpr int v_rd_off(int d0, int ks, int half) { return d0 * 512 + ks * 4096 + half * 2048; }
template <int OFF> __device__ __forceinline__ s16x4 tr_read(int vb) {
  s16x4 r; asm volatile("ds_read_b64_tr_b16 %0, %1 offset:%2" : "=&v"(r) : "v"(vb), "i"(OFF) : "memory"); return r;
}
template <int D0> __device__ __forceinline__ void pv_one(f32x16& od, int vb, bf16x8 pa0, bf16x8 pa1, bf16x8 pa2, bf16x8 pa3) {
  const s16x4 l0 = tr_read<v_rd_off(D0, 0, 0)>(vb), h0 = tr_read<v_rd_off(D0, 0, 1)>(vb), l1 = tr_read<v_rd_off(D0, 1, 0)>(vb), h1 = tr_read<v_rd_off(D0, 1, 1)>(vb);
  const s16x4 l2 = tr_read<v_rd_off(D0, 2, 0)>(vb), h2 = tr_read<v_rd_off(D0, 2, 1)>(vb), l3 = tr_read<v_rd_off(D0, 3, 0)>(vb), h3 = tr_read<v_rd_off(D0, 3, 1)>(vb);
  asm volatile("s_waitcnt lgkmcnt(0)" ::: "memory"); SBAR();
#define PK(L, H) (bf16x8){L[0], L[1], L[2], L[3], H[0], H[1], H[2], H[3]}
  od = __builtin_amdgcn_mfma_f32_32x32x16_bf16(pa0, PK(l0, h0), od, 0, 0, 0);
  od = __builtin_amdgcn_mfma_f32_32x32x16_bf16(pa1, PK(l1, h1), od, 0, 0, 0);
  od = __builtin_amdgcn_mfma_f32_32x32x16_bf16(pa2, PK(l2, h2), od, 0, 0, 0);
  od = __builtin_amdgcn_mfma_f32_32x32x16_bf16(pa3, PK(l3, h3), od, 0, 0, 0);
#undef PK
}
__device__ __forceinline__ void pv_d0(f32x16* o, int vb, bf16x8 pa0, bf16x8 pa1, bf16x8 pa2, bf16x8 pa3) {
  pv_one<0>(o[0], vb, pa0, pa1, pa2, pa3); pv_one<1>(o[1], vb, pa0, pa1, pa2, pa3); pv_one<2>(o[2], vb, pa0, pa1, pa2, pa3); pv_one<3>(o[3], vb, pa0, pa1, pa2, pa3);
}

struct AUnit {
  const bf16* Q;
  const bf16* K1; const bf16* V1; int s1, n1;
  const bf16* K2; const bf16* V2; int s2, n2;
  bf16* O;
  int rlo, qa;
  const float* rpb;
};

template <int KIND, int PASS>
__device__ __forceinline__ void attn_unit(const AUnit& U, LAS char* lds, int tid_in, float lam, float onemli, const float* dg, float* stash) {
  int tid = tid_in; asm volatile("" : "+v"(tid));
  constexpr int ND0 = (KIND == 2) ? 4 : 8;
  constexpr float SCALE = Sc<KIND>::SCALE;
  const int wid = __builtin_amdgcn_readfirstlane(tid >> 6), lane = tid & 63, r32 = lane & 31, hi = lane >> 5;
  LAS char* V_lds = lds; LAS char* K_lds = lds + 2 * SHM_V;
  LAS float* wsl = (LAS float*)(lds + OFF_WS) + wid * 64; LAS float* li_l = wsl; LAS float* al_l = wsl + 32;
  LAS float* btab = (LAS float*)(lds + OFF_BT);
  const int NT = U.n1 + U.n2;
  const int sr = tid >> 4, sc = (tid & 15) * 8, vst0 = v_st(sr, sc), vst1 = v_st(32 + sr, sc);
  const int vb0 = (int)(unsigned)(uintptr_t)V_lds + v_rd_base(lane);
  int na_rq = 0, na_r0 = 0, na_t = 0, na_b = 0;
  if (KIND == 1) {
    for (int i = tid; i < 576; i += 512) btab[i] = (i >= 48 && i < 48 + 465) ? U.rpb[i - 48] * (1.0f / SCALE) : 0.f;
    const int cq = 32 * (wid & 1) + r32; na_rq = 4 * U.qa + (wid >> 1); na_r0 = min(max(na_rq - 4, 0), 8);
    na_t = 4 * hi - min(max(cq - 8, 0), 48); na_b = 48 + 4 * hi - cq + 15;
  }
  {
  constexpr int pass = PASS; constexpr int dbase = (KIND == 2) ? PASS * 64 : 0;
  float m_reg = -1e30f, l_reg = 0; f32x16 o[4] = {}; bf16x8 qr[ND0];
  { const bf16* Qw = U.Q + (size_t)(wid * QBLK + r32) * DIN + hi * 8 + dbase;
#pragma unroll
    for (int d0 = 0; d0 < ND0; ++d0) qr[d0] = *(const bf16x8*)(Qw + d0 * 16); }
  struct { bf16x8 vs0, vs1, ks0, ks1; } sr_[2];
#define TILE_PTRS(j) const bool s2_ = (j) >= U.n1; const int tt_ = s2_ ? (j) - U.n1 : (j); const int st_ = s2_ ? U.s2 : U.s1; \
    const bf16* Kt_ = (s2_ ? U.K2 : U.K1) + (size_t)tt_ * 64 * st_; const bf16* Vt_ = (s2_ ? U.V2 : U.V1) + (size_t)tt_ * 64 * st_;
#define SLOAD(i, j) do { TILE_PTRS(j) sr_[i].vs0 = *(const bf16x8*)(Vt_ + (size_t)sr * st_ + sc); sr_[i].vs1 = *(const bf16x8*)(Vt_ + (size_t)(32 + sr) * st_ + sc); \
    sr_[i].ks0 = *(const bf16x8*)(Kt_ + (size_t)sr * st_ + sc); sr_[i].ks1 = *(const bf16x8*)(Kt_ + (size_t)(32 + sr) * st_ + sc); } while (0)
#define SWRITE(b, i) do { *(LAS bf16x8*)(V_lds + (b) * SHM_V + vst0) = sr_[i].vs0; *(LAS bf16x8*)(V_lds + (b) * SHM_V + vst1) = sr_[i].vs1; const int kc = sc * 2; \
    *(LAS bf16x8*)(K_lds + (b) * SHM_K + KSWZ(sr, kc)) = sr_[i].ks0; *(LAS bf16x8*)(K_lds + (b) * SHM_K + KSWZ(32 + sr, kc)) = sr_[i].ks1; } while (0)
#define SWAIT() asm volatile("s_waitcnt vmcnt(4)" ::: "memory")
#define RESC(a) do { if (__any((a) < 1.f)) { if (hi == 0) al_l[r32] = (a); asm volatile("s_waitcnt lgkmcnt(0)" ::: "memory"); \
    _Pragma("unroll") for (int d = 0; d < 4; ++d) _Pragma("unroll") for (int r = 0; r < 16; ++r) o[d][r] *= al_l[crow(r, hi)]; } } while (0)
#define NABIAS(P0, P1, j) do { if (KIND == 1 && (j) >= U.n1) { const int rk = U.rlo + (j) - U.n1; const bool inw = (unsigned)(rk - na_r0) < 8u; \
    const int dr = min(max(rk - na_rq + 7, 0), 14); const LAS float* bp = btab + dr * 31 + na_b; const int tt = inw ? na_t : 1000; \
    _Pragma("unroll") for (int r = 0; r < 16; ++r) { const int co = (r & 3) + 8 * (r >> 2); \
      P0[r] = ((unsigned)(co + tt) < 16u) ? P0[r] + bp[co] : -1e30f; P1[r] = ((unsigned)(co + 32 + tt) < 16u) ? P1[r] + bp[co + 32] : -1e30f; } } } while (0)
  f32x16 pA0, pA1, pB0, pB1; float mnA, mnB, alA, alB; bf16x8 pa0, pa1, pa2, pa3;
  constexpr int SE = 0, SO = 1;
  __syncthreads();
  SLOAD(SE, 0); asm volatile("s_waitcnt vmcnt(0)" ::: "memory"); SWRITE(0, SE); __syncthreads();
  qkt<ND0>(pA0, pA1, K_lds, qr, r32, hi, dbase); NABIAS(pA0, pA1, 0); partialSM<KIND>(pA0, pA1, m_reg, mnA, alA);
  SLOAD(SO, 1); SLOAD(SE, 2);
  SWAIT(); SWRITE(1, SO); __syncthreads();
  for (int j = 1; j + 1 < NT; j += 2) {
    SBAR(); qkt<ND0>(pB0, pB1, K_lds + SHM_K, qr, r32, hi, dbase);
    finishSM(pA0, pA1, alA, l_reg, pa0, pa1, pa2, pa3); SBAR();
    SLOAD(SO, (j + 2 < NT) ? j + 2 : j); SBAR();
    pv_d0(o, vb0, pa0, pa1, pa2, pa3); NABIAS(pB0, pB1, j); partialSM<KIND>(pB0, pB1, m_reg, mnB, alB);
    __syncthreads(); SWAIT(); SWRITE(0, SE);
    RESC(alB); __syncthreads();
    SBAR(); qkt<ND0>(pA0, pA1, K_lds, qr, r32, hi, dbase);
    finishSM(pB0, pB1, alB, l_reg, pa0, pa1, pa2, pa3); SBAR();
    SLOAD(SE, (j + 3 < NT) ? j + 3 : NT - 1); SBAR();
    pv_d0(o, vb0 + SHM_V, pa0, pa1, pa2, pa3); NABIAS(pA0, pA1, j + 1); partialSM<KIND>(pA0, pA1, m_reg, mnA, alA);
    __syncthreads(); SWAIT(); SWRITE(1, SO);
    RESC(alA); __syncthreads();
  }
  SBAR(); qkt<ND0>(pB0, pB1, K_lds + SHM_K, qr, r32, hi, dbase);
  finishSM(pA0, pA1, alA, l_reg, pa0, pa1, pa2, pa3); SBAR();
  pv_d0(o, vb0, pa0, pa1, pa2, pa3); NABIAS(pB0, pB1, NT - 1); partialSM<KIND>(pB0, pB1, m_reg, mnB, alB);
  __syncthreads(); RESC(alB);
  finishSM(pB0, pB1, alB, l_reg, pa0, pa1, pa2, pa3); SBAR();
  pv_d0(o, vb0 + SHM_V, pa0, pa1, pa2, pa3);
  asm volatile("s_waitcnt vmcnt(0)" ::: "memory");
  if (hi == 0) li_l[r32] = l_reg; asm volatile("s_waitcnt lgkmcnt(0)" ::: "memory");
  float rli[16];
#pragma unroll
  for (int r = 0; r < 16; ++r) rli[r] = __builtin_amdgcn_rcpf(li_l[crow(r, hi)]);
  if (KIND != 2) {
    bf16* Ow = U.O + (size_t)(wid * QBLK) * DM;
#pragma unroll
    for (int r = 0; r < 16; ++r) { const int orow = crow(r, hi);
#pragma unroll
      for (int d0 = 0; d0 < 4; ++d0) Ow[(size_t)orow * DM + d0 * 32 + r32] = (bf16)f2bf(o[d0][r] * rli[r]); }
  } else if (pass == 0) {
#pragma unroll
    for (int d0 = 0; d0 < 4; ++d0) { float* sw = stash + wid * 4096 + d0 * 1024 + lane;
#pragma unroll
      for (int r = 0; r < 16; ++r) sw[r * 64] = o[d0][r] * rli[r]; }
  } else {
    float gcol[4];
#pragma unroll
    for (int d0 = 0; d0 < 4; ++d0) gcol[d0] = dg[d0 * 32 + r32] * onemli;
    bf16* Ow = U.O + (size_t)(wid * QBLK) * DM;
#pragma unroll
    for (int r = 0; r < 16; ++r) {
      float v[4]; float ss = 0.f;
#pragma unroll
      for (int d0 = 0; d0 < 4; ++d0) { v[d0] = stash[wid * 4096 + d0 * 1024 + lane + r * 64] - lam * (o[d0][r] * rli[r]); ss += v[d0] * v[d0]; }
#pragma unroll
      for (int off = 1; off < 32; off <<= 1) ss += __shfl_xor(ss, off);
      const float rs = 1.0f / sqrtf(ss * (1.0f / 128.0f) + EPS);
      const int orow = crow(r, hi);
#pragma unroll
      for (int d0 = 0; d0 < 4; ++d0) Ow[(size_t)orow * DM + d0 * 32 + r32] = (bf16)f2bf(v[d0] * rs * gcol[d0]);
      asm volatile("" ::: "memory");
    }
  }
  }
#undef TILE_PTRS
#undef SLOAD
#undef SWRITE
#undef SWAIT
#undef RESC
#undef NABIAS
}
#undef KSWZ
#undef SBAR
}

constexpr int CW_ATTQ = 3584;
constexpr size_t WS_STASH = 896 * MiB;
constexpr size_t WS_END2 = 976 * MiB;

__device__ __forceinline__ int attq_next(unsigned* ctr, LAS char* lds, int tid) {
  LAS int* slot = (LAS int*)(lds + att::OFF_Q);
  __syncthreads();
  if (tid == 0) *slot = (int)__hip_atomic_fetch_add(ctr, 1u, __ATOMIC_RELAXED, __HIP_MEMORY_SCOPE_AGENT);
  __syncthreads();
  return *slot;
}

#ifndef PROBE_SITE
#define PROBE_SITE -1
#endif
__device__ __forceinline__ void ph_attn(CArgs* a, const Ctx& X, int l, int rep, unsigned long long& pacc) {
  unsigned char* ws = a->ws;
  const bf16* QKV = (const bf16*)(ws + WS_QKV); bf16* AO = (bf16*)(ws + WS_AO);
  unsigned* ctl = (unsigned*)(ws + WS_CTL);
  LAS char* lds = (LAS char*)X.lds;
#ifndef AMASK
#define AMASK 7
#endif
  if (AMASK & 1)
  for (;;) {
    unsigned long long tq_ = 0; if (PROBE_SITE == 13) tq_ = __builtin_amdgcn_s_memrealtime();
    const int i = attq_next(ctl + CW_ATTQ + 64 * (3 * l + 0 + 12 * rep), lds, X.tid);
    if (PROBE_SITE == 13) pacc += __builtin_amdgcn_s_memrealtime() - tq_;
    if (i >= 192) break;
    if (PROBE_SITE == 14) tq_ = __builtin_amdgcn_s_memrealtime();
    att::AUnit U{};
    if (i < 128) { const int b = i >> 4, h = (i >> 2) & 3, qb = i & 3; const size_t r0 = (size_t)NCTX + b * LAT_T;
      U.Q = QKV + (r0 + qb * 256) * DIN + C_DQ + h * 128; U.O = AO + (r0 + qb * 256) * DM + AO_D + h * 128;
      const size_t co = ((size_t)(b * DEPTH + l) * PAST) * 512 + h * 128;
      U.K1 = (const bf16*)(ws + WS_CDK) + co; U.V1 = (const bf16*)(ws + WS_CDV) + co; U.s1 = 512; U.n1 = 4;
      U.K2 = QKV + r0 * DIN + C_DK + h * 128; U.V2 = QKV + r0 * DIN + C_DV + h * 128; U.s2 = DIN; U.n2 = 16;
    } else { const int j = i - 128, b = j >> 2, h = j & 3; const size_t r0 = (size_t)b * CTX_T;
      U.Q = QKV + r0 * DIN + C_DQ + h * 128; U.O = AO + r0 * DM + AO_D + h * 128;
      U.K1 = QKV + r0 * DIN + C_DK + h * 128; U.V1 = QKV + r0 * DIN + C_DV + h * 128; U.s1 = DIN; U.n1 = 4; U.K2 = U.K1; U.V2 = U.V1; U.s2 = DIN; U.n2 = 0; }
    #ifndef DPASS
#define DPASS 3
#endif
    float* stash = (float*)(ws + WS_STASH) + (size_t)blockIdx.x * 32768;
    const float li = lambda_init_of(l);
    const float* lamv = a->in[I_LAM] + l * 256;
    const float lam = expf(wave_sum(lamv[X.lane] * lamv[64 + X.lane])) - expf(wave_sum(lamv[128 + X.lane] * lamv[192 + X.lane])) + li;
    const float* dg = a->in[I_DG] + l * 128;
    if (DPASS & 1) att::attn_unit<2, 0>(U, lds, X.tid, lam, 1.0f - li, dg, stash);
    if (DPASS & 2) att::attn_unit<2, 1>(U, lds, X.tid, lam, 1.0f - li, dg, stash);
    if (PROBE_SITE == 14) pacc += __builtin_amdgcn_s_memrealtime() - tq_;
  }
  if (AMASK & 2)
  for (;;) {
    unsigned long long tq_ = 0; if (PROBE_SITE == 13) tq_ = __builtin_amdgcn_s_memrealtime();
    const int i = attq_next(ctl + CW_ATTQ + 64 * (3 * l + 1 + 12 * rep), lds, X.tid);
    if (PROBE_SITE == 13) pacc += __builtin_amdgcn_s_memrealtime() - tq_;
    if (i >= 128) break;
    if (PROBE_SITE == 15) tq_ = __builtin_amdgcn_s_memrealtime();
    att::AUnit U{};
    const int b = i >> 4, h = (i >> 2) & 3, qb = i & 3; const size_t r0 = (size_t)NCTX + b * LAT_T;
    U.Q = QKV + (r0 + qb * 256) * DIN + C_NAQ + h * 128; U.O = AO + (r0 + qb * 256) * DM + AO_NA + h * 128;
    const size_t co = ((size_t)(b * DEPTH + l) * PAST) * 512 + h * 128;
    U.K1 = (const bf16*)(ws + WS_CNAK) + co; U.V1 = (const bf16*)(ws + WS_CNAV) + co; U.s1 = 512; U.n1 = 4;
    U.rlo = (qb == 0) ? 0 : (qb == 1) ? 0 : (qb == 2) ? 4 : 8; U.n2 = (qb == 0 || qb == 3) ? 8 : 12; U.qa = qb;
    U.K2 = QKV + (r0 + U.rlo * 64) * DIN + C_NAK + h * 128; U.V2 = QKV + (r0 + U.rlo * 64) * DIN + C_NAV + h * 128; U.s2 = DIN;
    U.rpb = a->in[I_RPB] + (size_t)(l * 4 + h) * 465;
    att::attn_unit<1, 0>(U, lds, X.tid, 0.f, 0.f, nullptr, nullptr);
    if (PROBE_SITE == 15) pacc += __builtin_amdgcn_s_memrealtime() - tq_;
  }
  if (AMASK & 4)
  for (;;) {
    unsigned long long tq_ = 0; if (PROBE_SITE == 13) tq_ = __builtin_amdgcn_s_memrealtime();
    const int i = attq_next(ctl + CW_ATTQ + 64 * (3 * l + 2 + 12 * rep), lds, X.tid);
    if (PROBE_SITE == 13) pacc += __builtin_amdgcn_s_memrealtime() - tq_;
    if (i >= 448) break;
    if (PROBE_SITE == 16) tq_ = __builtin_amdgcn_s_memrealtime();
    att::AUnit U{};
    if (i < 256) { const int b = i >> 5, hq = (i >> 2) & 7, qb = i & 3, kvh = hq >> 2; const size_t r0 = (size_t)NCTX + b * LAT_T;
      U.Q = QKV + (r0 + qb * 256) * DIN + C_GQ + hq * 128; U.O = AO + (r0 + qb * 256) * DM + AO_G + hq * 128;
      const size_t co = ((size_t)(b * DEPTH + l) * PAST) * 256 + kvh * 128;
      U.K1 = (const bf16*)(ws + WS_CGK) + co; U.V1 = (const bf16*)(ws + WS_CGV) + co; U.s1 = 256; U.n1 = 4;
      U.K2 = QKV + r0 * DIN + C_GK + kvh * 128; U.V2 = QKV + r0 * DIN + C_GV + kvh * 128; U.s2 = DIN; U.n2 = 16;
    } else if (i < 384) { const int j = i - 256, b = j >> 3, hq = j & 7, kvh = hq >> 2; const size_t r0 = (size_t)b * CTX_T;
      U.Q = QKV + r0 * DIN + C_GQ + hq * 128; U.O = AO + r0 * DM + AO_G + hq * 128;
      U.K1 = QKV + r0 * DIN + C_GK + kvh * 128; U.V1 = QKV + r0 * DIN + C_GV + kvh * 128; U.s1 = DIN; U.n1 = 4; U.K2 = U.K1; U.V2 = U.V1; U.s2 = DIN; U.n2 = 0;
    } else { const int j = i - 384, b = j >> 2, h = j & 3; const size_t r0 = (size_t)b * CTX_T;
      U.Q = QKV + r0 * DIN + C_NAQ + h * 128; U.O = AO + r0 * DM + AO_NA + h * 128;
      U.K1 = QKV + r0 * DIN + C_NAK + h * 128; U.V1 = QKV + r0 * DIN + C_NAV + h * 128; U.s1 = DIN; U.n1 = 4; U.K2 = U.K1; U.V2 = U.V1; U.s2 = DIN; U.n2 = 0; }
    att::attn_unit<0, 0>(U, lds, X.tid, 0.f, 0.f, nullptr, nullptr);
    if (PROBE_SITE == 16) pacc += __builtin_amdgcn_s_memrealtime() - tq_;
  }
}

constexpr int NPHASE = 2 + 8 * DEPTH;
#ifndef IN_FUSED
#define IN_FUSED 2
#endif
#ifndef INMASK
#define INMASK 7
#endif
#ifndef ATTN_NAIVE
#define ATTN_NAIVE 0
#endif
#ifndef MK_SINGLE
#define MK_SINGLE 1
#endif
__global__ void __launch_bounds__(NTHREADS, 2) fwd(Args args_unused) {
    extern __shared__ __attribute__((aligned(16))) unsigned char lds_raw[];
#define CTX_HERE() Ctx X; { int t_ = threadIdx.x; asm volatile("" : "+v"(t_)); X.lds = (LAS unsigned char*)lds_raw; X.tid = t_; X.lane = t_ & 63; X.wave = __builtin_amdgcn_readfirstlane(t_ >> 6); \
    X.G = gridDim.x; const int bx_ = blockIdx.x; X.vcu = (X.G % 8 == 0) ? (bx_ % 8) * (X.G / 8) + bx_ / 8 : bx_; X.gw = X.vcu * NWAVES + X.wave; X.NGW = X.G * NWAVES; }
    LAS unsigned char* const lds0 = (LAS unsigned char*)lds_raw;
    for (int u = threadIdx.x; u < (LDS_BYTES - LDSCTL_OFF) / 4; u += NTHREADS) ((LAS unsigned*)(lds0 + LDSCTL_OFF))[u] = 0u;
    __syncthreads();
    int lo, hi; XcdBarrier bar;
    { CArgs* A = args_here(); lo = A->ph_lo; hi = A->ph_hi; unsigned* ctl = (unsigned*)(A->ws + WS_CTL);
      bar.bar = ctl + CW_BAR; bar.x = 0; bar.st = nullptr;
      if (hi - lo > 1) bar = xcd_barrier_post(ctl + CW_BAR, (volatile LAS unsigned*)(lds0 + MISC_OFF) + 8); }
#ifndef PHMASK
#define PHMASK 0xffff
#endif
#ifndef PROBE_SITE
#define PROBE_SITE -1
#endif
#ifndef PROBE_MULT
#define PROBE_MULT 1
#endif
    unsigned long long pt0_ = 0, pacc_ = 0;
#define PT0(n) do { if (PROBE_SITE == (n)) pt0_ = __builtin_amdgcn_s_memrealtime(); } while (0)
#define PT1(n) do { if (PROBE_SITE == (n)) pacc_ += (__builtin_amdgcn_s_memrealtime() - pt0_) * PROBE_MULT; } while (0)
#define IN(k) (lo <= (k) && (k) < hi)
#define ON(n) ((PHMASK >> (n)) & 1)
#ifndef REPMASK
#define REPMASK 0
#endif
#define REPS(n) (((REPMASK >> (n)) & 1) ? 2 : 1)
#ifndef BARREP
#define BARREP 1
#endif
#define SEAM(k) do { if (IN(k) && IN((k) + 1)) { for (int br_ = 0; br_ < BARREP; ++br_) xcd_barrier(bar); } } while (0)

    if (ON(0) && IN(0)) { PT0(0); CTX_HERE(); CArgs* A = args_here(); for (int rep = 0; rep < REPS(0); ++rep) { ph_prologue(A, X); __syncthreads(); } SEAM(0); PT1(0); }
    if (ON(1) && IN(1)) { PT0(1); CTX_HERE(); CArgs* A = args_here(); norm_rows<true, false>(A, X, nullptr, nullptr, nullptr, 0, A->in[I_NORMG], (const float*)(A->ws + WS_MOD), 0, 2048); SEAM(1); PT1(1); }

    for (int l = 0; l < DEPTH; ++l) {
        const int pb = 2 + 8 * l;
        if (ON(2) && IN(pb + 0)) { PT0(2);
            CArgs* A = args_here(); unsigned char* ws = A->ws;
            pg8::Gemm g{(const bf16*)(ws + WS_H), (const bf16*)(ws + WS_WIN) + (size_t)l * DIN * DM, MTOK, DIN, DM};
#if IN_FUSED == 2
            { pg8::InOrder S; S.init(MTOK, DIN, (int)gridDim.x, (int)blockIdx.x);
              pg8::EpiInAll E{pg8::EpiInP{(bf16*)(ws + WS_QKV), A->out, l},
                              pg8::EpiInG{(bf16*)(ws + WS_QKV), A->out, l, A->in[I_QG] + l * 128, A->in[I_KG] + l * 128, (const float*)(ws + WS_ROPE), (LAS float*)(lds0 + RING_BYTES + 1024)},
                              pg8::EpiInD{(bf16*)(ws + WS_QKV), A->out, l, (const float*)(ws + WS_ROPE)}};
              pg8::gemm_phase<pg8::EpiInAll, pg8::InOrder, true, true>(lds0 + RING_OFF, g, S, E); }
            SEAM(pb + 0); PT1(2);
#elif IN_FUSED
            if (INMASK & 1) { PT0(10); pg8::SubOrder<0> S; S.init(MTOK, 9 * 256, (int)gridDim.x, (int)blockIdx.x); pg8::EpiInP E{(bf16*)(ws + WS_QKV), A->out, l};
              pg8::gemm_phase<pg8::EpiInP, pg8::SubOrder<0>, true, true>(lds0 + RING_OFF, g, S, E); PT1(10); }
            if (INMASK & 2) { PT0(11); pg8::SubOrder<1> S; S.init(MTOK, 5 * 256, (int)gridDim.x, (int)blockIdx.x);
              pg8::EpiInG E{(bf16*)(ws + WS_QKV), A->out, l, A->in[I_QG] + l * 128, A->in[I_KG] + l * 128, (const float*)(ws + WS_ROPE), (LAS float*)(lds0 + RING_BYTES + 1024)};
              pg8::gemm_phase<pg8::EpiInG, pg8::SubOrder<1>, true, true>(lds0 + RING_OFF, g, S, E); PT1(11); }
            if (INMASK & 4) { PT0(12); pg8::SubOrder<2> S; S.init(MTOK, 4 * 256, (int)gridDim.x, (int)blockIdx.x); pg8::EpiInD E{(bf16*)(ws + WS_QKV), A->out, l, (const float*)(ws + WS_ROPE)};
              pg8::gemm_phase<pg8::EpiInD, pg8::SubOrder<2>, true, true>(lds0 + RING_OFF, g, S, E); PT1(12); }
            SEAM(pb + 0); PT1(2);
#else
            { pg8::StaticOrder S; S.init(MTOK, DIN, (int)gridDim.x, (int)blockIdx.x); pg8::EpiBf16<0> E{(bf16*)(ws + WS_QKV), DIN};
              pg8::gemm_phase<pg8::EpiBf16<0>, pg8::StaticOrder, true, true>(lds0 + RING_OFF, g, S, E); }
            xcd_barrier(bar); PT1(2);
            { PT0(3); CTX_HERE(); ph_fixup(A, X, l); SEAM(pb + 0); PT1(3); }
#endif
        }
        if (ON(4) && IN(pb + 2)) { PT0(4); CTX_HERE(); CArgs* A = args_here();
#if ATTN_NAIVE
            ph_attn_naive(A, X, l);
#else
            for (int rep = 0; rep < REPS(4); ++rep) ph_attn(A, X, l, rep, pacc_);
#endif
            SEAM(pb + 2); PT1(4); }
        if (ON(5) && IN(pb + 3)) { PT0(5);
            CArgs* A = args_here(); unsigned char* ws = A->ws;
            pg8::Gemm g{(const bf16*)(ws + WS_AO), (const bf16*)(ws + WS_WOUT) + (size_t)l * DM * DM, MTOK, DM, DM}; pg8::SplitTailOrder S; S.init(g.K, (int)gridDim.x, (int)blockIdx.x);
            pg8::EpiBf16Split E{(bf16*)(ws + WS_O2), (bf16*)(ws + WS_O2B)};
            for (int rep = 0; rep < REPS(5); ++rep) pg8::gemm_phase<pg8::EpiBf16Split, pg8::SplitTailOrder, true, true>(lds0 + RING_OFF, g, S, E);
            SEAM(pb + 3); PT1(5);
        }
        if (ON(6) && IN(pb + 4)) { PT0(6); CTX_HERE(); CArgs* A = args_here(); const float* normg = A->in[I_NORMG]; const float* modl = (const float*)(A->ws + WS_MOD) + (size_t)l * 9 * NMODW;
            norm_rows<false, false>(A, X, (const bf16*)(A->ws + WS_O2), normg + (size_t)(l * 4 + 1) * DM, modl, 4096, normg + (size_t)(l * 4 + 2) * DM, modl, 6144, 8192); SEAM(pb + 4); PT1(6); }
        if (ON(7) && IN(pb + 5)) { PT0(7);
            CArgs* A = args_here(); unsigned char* ws = A->ws;
            pg8::Gemm g{(const bf16*)(ws + WS_H), (const bf16*)(ws + WS_WUP) + (size_t)l * DFF * DM, MTOK, DFF, DM}; pg8::StaticOrder S; S.init(MTOK, DFF, (int)gridDim.x, (int)blockIdx.x);
            pg8::EpiBf16<2> E{(bf16*)(ws + WS_U), DFF};
            for (int rep = 0; rep < REPS(7); ++rep) pg8::gemm_phase<pg8::EpiBf16<2>, pg8::StaticOrder, true, true>(lds0 + RING_OFF, g, S, E);
            SEAM(pb + 5); PT1(7);
        }
        if (ON(8) && IN(pb + 6)) { PT0(8);
            CArgs* A = args_here(); unsigned char* ws = A->ws;
            pg8::Gemm g{(const bf16*)(ws + WS_U), (const bf16*)(ws + WS_WDN) + (size_t)l * DM * DFF, MTOK, DM, DFF}; pg8::SplitTailOrder S; S.init(g.K, (int)gridDim.x, (int)blockIdx.x);
            pg8::EpiBf16Split E{(bf16*)(ws + WS_O2), (bf16*)(ws + WS_O2B)};
            for (int rep = 0; rep < REPS(8); ++rep) pg8::gemm_phase<pg8::EpiBf16Split, pg8::SplitTailOrder, true, true>(lds0 + RING_OFF, g, S, E);
            SEAM(pb + 6); PT1(8);
        }
        if (ON(9) && IN(pb + 7)) { PT0(9);
            CTX_HERE(); CArgs* A = args_here(); const float* normg = A->in[I_NORMG]; const float* mod_all = (const float*)(A->ws + WS_MOD);
            const int ln = (l + 1 < DEPTH) ? l + 1 : l;
            if (l + 1 < DEPTH) norm_rows<false, false>(A, X, (const bf16*)(A->ws + WS_O2), normg + (size_t)(l * 4 + 3) * DM, mod_all + (size_t)l * 9 * NMODW, 10240, normg + (size_t)(ln * 4 + 0) * DM, mod_all + (size_t)ln * 9 * NMODW, 0, 2048);
            else norm_rows<false, true>(A, X, (const bf16*)(A->ws + WS_O2), normg + (size_t)(l * 4 + 3) * DM, mod_all + (size_t)l * 9 * NMODW, 10240, nullptr, nullptr, 0, 0);
            SEAM(pb + 7); PT1(9);
        }
    }
    if (PROBE_SITE >= 0) { const unsigned long long tgt_ = __builtin_amdgcn_s_memrealtime() + pacc_; while (__builtin_amdgcn_s_memrealtime() < tgt_) __builtin_amdgcn_s_sleep(32); }
#undef IN
#undef SEAM
}

extern "C" void kernel_launch(void* const* d_in, const int* in_sizes, int n_in, void* d_out, int out_size, void* d_ws, size_t ws_size, hipStream_t stream) {
    static int grid = 0;
    if (grid == 0) {
        if (n_in != 22 || out_size != (int)OUT_END || ws_size < WS_END2) { fprintf(stderr, "kernel_launch: unexpected shapes: n_in %d out %d ws %zu\n", n_in, out_size, ws_size); grid = -1; return; }
        int dev = 0, cus = 0, per_cu = 0;
        if (hipGetDevice(&dev) != hipSuccess || hipDeviceGetAttribute(&cus, hipDeviceAttributeMultiprocessorCount, dev) != hipSuccess) { grid = -1; return; }
        if (hipFuncSetAttribute((const void*)fwd, hipFuncAttributeMaxDynamicSharedMemorySize, LDS_BYTES) != hipSuccess) { fprintf(stderr, "kernel_launch: hipFuncSetAttribute failed\n"); grid = -1; return; }
        if (hipOccupancyMaxActiveBlocksPerMultiprocessor(&per_cu, (const void*)fwd, NTHREADS, LDS_BYTES) != hipSuccess || per_cu < 1) fprintf(stderr, "kernel_launch: occupancy query says %d\n", per_cu);
        (void)hipGetLastError();
        grid = cus;
    }
    if (grid < 0) return;
    (void)hipMemsetAsync((char*)d_ws + WS_CTL, 0, CTL_ZERO_BYTES, stream);
    Args a{};
    for (int i = 0; i < 22; ++i) a.in[i] = (const float*)d_in[i];
    a.out = (float*)d_out; a.ws = (unsigned char*)d_ws;
#if MK_SINGLE
    a.ph_lo = 0; a.ph_hi = NPHASE;
    hipLaunchKernelGGL(fwd, dim3(grid), dim3(NTHREADS), LDS_BYTES, stream, a);
#else
    for (int p = 0; p < NPHASE; ++p) { a.ph_lo = p; a.ph_hi = p + 1; hipLaunchKernelGGL(fwd, dim3(grid), dim3(NTHREADS), LDS_BYTES, stream, a); }
#endif
    const hipError_t le = hipPeekAtLastError();
    if (le != hipSuccess) fprintf(stderr, "kernel_launch: launch failed: %s\n", hipGetErrorName(le));
}
```

```cpp
#include <hip/hip_runtime.h>
#include <cstdio>
#include <cstdint>
#include <cmath>
namespace pg8 {
#define PG8_LAS __attribute__((address_space(3)))
typedef unsigned short bf16_t;
typedef short bf16x8 __attribute__((ext_vector_type(8)));
typedef float f32x4 __attribute__((ext_vector_type(4)));
typedef unsigned u32x4 __attribute__((ext_vector_type(4)));
constexpr int BM = 256, BK = 64, HALF = 128, HTB = HALF * BK * 2  , STAGE_BYTES = 8 * HTB, NXCD = 8, WGM = 8;

__host__ __device__ __forceinline__ int lds_byte(int r, int c) { const int st = (r >> 4) * 2 + (c >> 5), rr = r & 15, cc = c & 31, ob = rr * 64 + cc * 2; return st * 1024 + (ob ^ (((ob >> 9) & 1) << 5)); }
__host__ __device__ __forceinline__ void stage_rc(int b, int& R, int& C) { const int st = b / 1024, sb = b % 1024, swz = sb ^ (((sb >> 9) & 1) << 5); R = (st >> 1) * 16 + swz / 64; C = (st & 1) * 32 + (swz % 64) / 2; }
__host__ __device__ __forceinline__ int perm32(int rho) { const int n = rho >> 4, i = rho & 15; return 8 * (i >> 2) + 4 * n + (i & 3); }

struct Unit { int pm, pn, k0, nt; };
struct Gemm { const bf16_t* A; const bf16_t* Bt; int M, N, K; };

struct StaticOrder {
    static constexpr bool SPLITK = false;
    int nM, nN, nwg, G, c;
    __host__ __device__ void init(int M, int N, int G_, int c_) { nM = M / BM; nN = N / BM; nwg = nM * nN; G = G_; c = c_; }
    __host__ __device__ bool next(int i, Unit& u) const {
        const long L = (long)i * G + c; if (L >= nwg) return false;
        int wgid = (int)L; { const int q = nwg / NXCD, r = nwg % NXCD, xcd = wgid % NXCD, off = wgid / NXCD; wgid = (xcd < r ? xcd * (q + 1) : r * (q + 1) + (xcd - r) * q) + off; }
        const int nig = WGM * nN, gid = wgid / nig, fm = gid * WGM, gsz = (nM - fm) < WGM ? (nM - fm) : WGM;
        u.pm = fm + ((wgid % nig) % gsz); u.pn = (wgid % nig) / gsz; return true;
    }
    __device__ __forceinline__ void a_ready(const Unit&) const {}
    __device__ __forceinline__ void done(const Unit&) const {}
};

__device__ __forceinline__ unsigned cvt_pk_bf16(float lo, float hi) { unsigned r; asm volatile("v_cvt_pk_bf16_f32 %0, %1, %2" : "=v"(r) : "v"(lo), "v"(hi)); return r; }
#ifndef EPI_WT
#define EPI_WT 0
#endif
typedef unsigned u32x2w __attribute__((ext_vector_type(2)));
__device__ __forceinline__ void st16(void* p, u32x4 w) { if (EPI_WT) asm volatile("global_store_dwordx4 %0, %1, off sc1" :: "v"(p), "v"(w) : "memory"); else *(u32x4*)p = w; }
__device__ __forceinline__ void st16f(void* p, f32x4 w) { if (EPI_WT) asm volatile("global_store_dwordx4 %0, %1, off sc1" :: "v"(p), "v"(w) : "memory"); else __builtin_nontemporal_store(w, (f32x4*)p); }
__device__ __forceinline__ void st8(void* p, u32x2w w) { if (EPI_WT) asm volatile("global_store_dwordx2 %0, %1, off sc1" :: "v"(p), "v"(w) : "memory"); else *(u32x2w*)p = w; }
struct EpiF32 {
    static constexpr bool AFTER_DRAIN = false; static constexpr int NKIND = 1; static __device__ __forceinline__ int kind(const Unit&) { return 0; } static __device__ __forceinline__ int browk(int, int R) { return brow(R); } static __device__ __forceinline__ int brow(int R) { return R; }
    float* C; int ldc;
    __device__ __forceinline__ void operator()(const f32x4 (&acc)[2][2][4][2], const Unit& u, int wr, int wc, int fr_in, int fq) const {
        int fr = fr_in; asm volatile("" : "+v"(fr));
        const int row0 = u.pm * BM + wr * 64 + fr, col0 = u.pn * BM + wc * 32 + 4 * fq;
#pragma unroll
        for (int ai = 0; ai < 2; ++ai)
#pragma unroll
            for (int m = 0; m < 4; ++m) { float* rowp = C + (size_t)(row0 + ai * HALF + m * 16) * ldc + col0;
#pragma unroll
                for (int bj = 0; bj < 2; ++bj)
#pragma unroll
                    for (int n = 0; n < 2; ++n) *(f32x4*)(rowp + bj * HALF + n * 16) = acc[ai][bj][m][n]; }
    }
};
template <int ACT  > struct EpiBf16 {
    static constexpr bool AFTER_DRAIN = false; static constexpr int NKIND = 1; static __device__ __forceinline__ int kind(const Unit&) { return 0; } static __device__ __forceinline__ int browk(int, int R) { return brow(R); } static __device__ __forceinline__ int brow(int R) { return (R & ~31) + perm32(R & 31); }
    bf16_t* O; int ldc;
    __device__ __forceinline__ void operator()(const f32x4 (&acc)[2][2][4][2], const Unit& u, int wr, int wc, int fr_in, int fq) const {
        int fr = fr_in; asm volatile("" : "+v"(fr));
        const int row0 = u.pm * BM + wr * 64 + fr; const int col0 = u.pn * BM + wc * 32 + 8 * fq;
#pragma unroll
        for (int ai = 0; ai < 2; ++ai)
#pragma unroll
            for (int m = 0; m < 4; ++m) { bf16_t* rowp = O + (size_t)(row0 + ai * HALF + m * 16) * ldc + col0;
#pragma unroll
                for (int bj = 0; bj < 2; ++bj) { f32x4 v0 = acc[ai][bj][m][0], v1 = acc[ai][bj][m][1];
                    if (ACT == 2) {
#pragma unroll
                        for (int j = 0; j < 4; ++j) { const float a = fmaxf(v0[j], 0.f), b = fmaxf(v1[j], 0.f); v0[j] = a * a; v1[j] = b * b; } }
                    u32x4 w; w.x = cvt_pk_bf16(v0[0], v0[1]); w.y = cvt_pk_bf16(v0[2], v0[3]); w.z = cvt_pk_bf16(v1[0], v1[1]); w.w = cvt_pk_bf16(v1[2], v1[3]);
                    st16(rowp + bj * HALF, w); } }
    }
};


template <int MB> struct EpiBf16R {
    static constexpr bool AFTER_DRAIN = false; static constexpr int NKIND = 1; static __device__ __forceinline__ int kind(const Unit&) { return 0; } static __device__ __forceinline__ int browk(int, int R) { return brow(R); } static __device__ __forceinline__ int brow(int R) { return (R & ~31) + perm32(R & 31); }
    bf16_t* O; int ldc;
    __device__ __forceinline__ void operator()(const f32x4 (&acc)[2][2][4][2], const Unit& u, int wr, int wc, int fr_in, int fq) const {
        int fr = fr_in; asm volatile("" : "+v"(fr));
        const int row0 = u.pm * (64 * MB) + wr * (16 * MB) + fr; const int col0 = u.pn * BM + wc * 32 + 8 * fq;
#pragma unroll
        for (int ai = 0; ai < 2; ++ai)
#pragma unroll
            for (int m = 0; m < MB; ++m) { bf16_t* rowp = O + (size_t)(row0 + ai * (32 * MB) + m * 16) * ldc + col0;
#pragma unroll
                for (int bj = 0; bj < 2; ++bj) { const f32x4 v0 = acc[ai][bj][m][0], v1 = acc[ai][bj][m][1];
                    u32x4 w; w.x = cvt_pk_bf16(v0[0], v0[1]); w.y = cvt_pk_bf16(v0[2], v0[3]); w.z = cvt_pk_bf16(v1[0], v1[1]); w.w = cvt_pk_bf16(v1[2], v1[3]);
                    st16(rowp + bj * HALF, w); } }
    }
};

struct SplitTailOrder {
    static constexpr bool SPLITK = true;
    int G, c, ntK;
    __device__ __forceinline__ void init(int K, int G_, int c_) { G = G_; c = c_; ntK = K / BK; }
    __device__ __forceinline__ bool next(int i, Unit& u) const {
        const int L = i * G + c; if (L >= 512) return false;
        const bool tail = L >= 256; const int T = tail ? L - 256 : L, x = T & 7, j = T >> 3;
        u.pm = tail ? 32 + x * 2 + (j >> 4) : x * 4 + (j >> 3); u.pn = tail ? ((j & 15) >> 1) : (j & 7);
        u.nt = tail ? (ntK >> 1) : ntK; u.k0 = tail ? (j & 1) * (ntK >> 1) * BK : 0;
        return true;
    }
    __device__ __forceinline__ void a_ready(const Unit&) const {}
    __device__ __forceinline__ void done(const Unit&) const {}
};
struct EpiBf16Split {
    static constexpr bool AFTER_DRAIN = false; static constexpr int NKIND = 1; static __device__ __forceinline__ int kind(const Unit&) { return 0; } static __device__ __forceinline__ int browk(int, int R) { return brow(R); } static __device__ __forceinline__ int brow(int R) { return (R & ~31) + perm32(R & 31); }
    bf16_t* O; bf16_t* O1;
    __device__ __forceinline__ void operator()(const f32x4 (&acc)[2][2][4][2], const Unit& u, int wr, int wc, int fr_in, int fq) const {
        int fr = fr_in; asm volatile("" : "+v"(fr));
        bf16_t* base = (u.k0 != 0) ? O1 + (size_t)(u.pm - 32) * BM * 2048 : O + (size_t)u.pm * BM * 2048;
        const int row0 = wr * 64 + fr; const int col0 = u.pn * BM + wc * 32 + 8 * fq;
#pragma unroll
        for (int ai = 0; ai < 2; ++ai)
#pragma unroll
            for (int m = 0; m < 4; ++m) { bf16_t* rowp = base + (size_t)(row0 + ai * HALF + m * 16) * 2048 + col0;
#pragma unroll
                for (int bj = 0; bj < 2; ++bj) { const f32x4 v0 = acc[ai][bj][m][0], v1 = acc[ai][bj][m][1];
                    u32x4 w; w.x = cvt_pk_bf16(v0[0], v0[1]); w.y = cvt_pk_bf16(v0[2], v0[3]); w.z = cvt_pk_bf16(v1[0], v1[1]); w.w = cvt_pk_bf16(v1[2], v1[3]);
                    st16(rowp + bj * HALF, w); } }
    }
};

typedef float f32x2e __attribute__((ext_vector_type(2)));
typedef unsigned u32x2 __attribute__((ext_vector_type(2)));
struct InOut { float* out; int l; };
struct EpiInP {
    static constexpr bool AFTER_DRAIN = false; static constexpr int NKIND = 1; static __device__ __forceinline__ int kind(const Unit&) { return 0; } static __device__ __forceinline__ int browk(int, int R) { return brow(R); } static __device__ __forceinline__ int brow(int R) { return (R & ~31) + perm32(R & 31); }
    bf16_t* O; float* out; int l;
    __device__ __forceinline__ void operator()(const f32x4 (&acc)[2][2][4][2], const Unit& u, int wr, int wc, int fr_in, int fq) const {
        int fr = fr_in; asm volatile("" : "+v"(fr));
        const int rin0 = wr * 64 + fr, col0 = u.pn * BM + wc * 32 + 8 * fq;
        float* ob = nullptr; int ow = 512;
        if (u.pm < 16) {
            if (u.pn >= 2 && u.pn <= 3) ob = out + 25165824 + (u.pn - 2) * 256; else if (u.pn >= 4 && u.pn <= 5) ob = out + 33554432 + (u.pn - 4) * 256;
            else if (u.pn == 11) { ob = out + 46137344; ow = 256; } else if (u.pn >= 16) ob = out + 58720256 + (u.pn - 16) * 256;
        }
#pragma unroll
        for (int ai = 0; ai < 2; ++ai)
#pragma unroll
            for (int m = 0; m < 4; ++m) { const int rin = rin0 + ai * HALF + m * 16; bf16_t* rowp = O + (size_t)(u.pm * BM + rin) * 4608 + col0;
#pragma unroll
                for (int bj = 0; bj < 2; ++bj) { const f32x4 v0 = acc[ai][bj][m][0], v1 = acc[ai][bj][m][1];
                    u32x4 w; w.x = cvt_pk_bf16(v0[0], v0[1]); w.y = cvt_pk_bf16(v0[2], v0[3]); w.z = cvt_pk_bf16(v1[0], v1[1]); w.w = cvt_pk_bf16(v1[2], v1[3]);
                    st16(rowp + bj * HALF, w);
                    if (ob) { float* d = ob + ((size_t)(u.pm * 4 + l) * 256 + rin) * ow + bj * HALF + wc * 32 + 8 * fq; st16f(d, v0); st16f(d + 4, v1); } } }
    }
};
struct EpiInG {
    static constexpr bool AFTER_DRAIN = false; static constexpr int NKIND = 1; static __device__ __forceinline__ int kind(const Unit&) { return 0; }
    static __device__ __forceinline__ int browk(int, int R) { return brow(R); } static __device__ __forceinline__ int brow(int R) { const int wc = R >> 5, n = (R >> 4) & 1, fq = (R >> 2) & 3, e = R & 3, g = 4 * wc + fq; return 4 * g + (g >= 8 ? 32 : 0) + 32 * n + e; }
    bf16_t* O; float* out; int l; const float* qg; const float* kg; const float* rope; PG8_LAS float* P;
    __device__ __forceinline__ void operator()(const f32x4 (&acc)[2][2][4][2], const Unit& u, int wr, int wc, int fr_in, int fq) const {
        int fr = fr_in; asm volatile("" : "+v"(fr));
        const int g = 4 * wc + fq, c = 4 * g + (g >= 8 ? 32 : 0);
        const int rin0 = wr * 64 + fr;
#pragma unroll
        for (int ai = 0; ai < 2; ++ai)
#pragma unroll
            for (int bj = 0; bj < 2; ++bj)
#pragma unroll
                for (int m = 0; m < 4; ++m) { const f32x4 a = acc[ai][bj][m][0], b = acc[ai][bj][m][1];
                    float s = (a[0] * a[0] + a[1] * a[1]) + (a[2] * a[2] + a[3] * a[3]) + (b[0] * b[0] + b[1] * b[1]) + (b[2] * b[2] + b[3] * b[3]);
                    s += __shfl_xor(s, 16); s += __shfl_xor(s, 32);
                    if (fq == 0) P[((ai * 2 + bj) * 128 + rin0 + m * 16) * 4 + wc] = s; }
        const float* gs = (u.pn == 10) ? kg : qg;
        const f32x4 gA = *(const f32x4*)(gs + c), gB = *(const f32x4*)(gs + c + 32);
        const bool lat = u.pm >= 16;
        const int fi = (wc < 2) ? c : c - 64;
        f32x4 cs[4][2];
#pragma unroll
        for (int k = 0; k < 4; ++k) { cs[k][0] = (f32x4){1.f, 0.f, 1.f, 0.f}; cs[k][1] = (f32x4){1.f, 0.f, 1.f, 0.f};
            if (lat) { const int pos = (wc < 2) ? 4 * (u.pm & 3) + 2 * (k & 1) + wr : 16 * k + fr; const float* rp = rope + (size_t)(pos * 48 + fi) * 2; cs[k][0] = *(const f32x4*)rp; cs[k][1] = *(const f32x4*)(rp + 4); } }
        asm volatile("s_waitcnt lgkmcnt(0)" ::: "memory"); __builtin_amdgcn_s_barrier(); asm volatile("" ::: "memory");
#pragma unroll
        for (int ai = 0; ai < 2; ++ai)
#pragma unroll
            for (int m = 0; m < 4; ++m) { const int rin = rin0 + ai * HALF + m * 16; bf16_t* rowp = O + (size_t)(u.pm * BM + rin) * 4608 + u.pn * BM + c;
                const f32x4 cs01 = (wc < 2) ? cs[ai][0] : cs[m][0], cs23 = (wc < 2) ? cs[ai][1] : cs[m][1];
#pragma unroll
                for (int bj = 0; bj < 2; ++bj) { const f32x4 t4 = *(const PG8_LAS f32x4*)(P + ((ai * 2 + bj) * 128 + rin0 + m * 16) * 4);
                    const float r = 1.0f / sqrtf(((t4[0] + t4[1]) + (t4[2] + t4[3])) * (1.0f / 128.0f) + 1e-6f);
                    const f32x4 x1 = acc[ai][bj][m][0] * r * gA, x2 = acc[ai][bj][m][1] * r * gB;
                    f32x4 y1, y2;
                    y1[0] = x1[0] * cs01[0] - x2[0] * cs01[1]; y2[0] = x2[0] * cs01[0] + x1[0] * cs01[1];
                    y1[1] = x1[1] * cs01[2] - x2[1] * cs01[3]; y2[1] = x2[1] * cs01[2] + x1[1] * cs01[3];
                    y1[2] = x1[2] * cs23[0] - x2[2] * cs23[1]; y2[2] = x2[2] * cs23[0] + x1[2] * cs23[1];
                    y1[3] = x1[3] * cs23[2] - x2[3] * cs23[3]; y2[3] = x2[3] * cs23[2] + x1[3] * cs23[3];
                    u32x2 w1, w2; w1.x = cvt_pk_bf16(y1[0], y1[1]); w1.y = cvt_pk_bf16(y1[2], y1[3]); w2.x = cvt_pk_bf16(y2[0], y2[1]); w2.y = cvt_pk_bf16(y2[2], y2[3]);
                    st8(rowp + bj * HALF, w1); st8(rowp + bj * HALF + 32, w2);
                    if (u.pn == 10 && !lat) { float* d = out + 41943040 + ((size_t)(u.pm * 4 + l) * 256 + rin) * 256 + bj * HALF + c; st16f(d, x1); st16f(d + 32, x2); } } }
    }
};
struct EpiInD {
    static constexpr bool AFTER_DRAIN = false; static constexpr int NKIND = 1; static __device__ __forceinline__ int kind(const Unit&) { return 0; }
    static __device__ __forceinline__ int browk(int, int R) { return brow(R); } static __device__ __forceinline__ int brow(int R) { const int wc = R >> 5, n = (R >> 4) & 1, fq = (R >> 2) & 3, e = R & 3; return 32 * wc + 4 * fq + 16 * n + e; }
    bf16_t* O; float* out; int l; const float* rope;
    __device__ __forceinline__ void operator()(const f32x4 (&acc)[2][2][4][2], const Unit& u, int wr, int wc, int fr_in, int fq) const {
        int fr = fr_in; asm volatile("" : "+v"(fr));
        const int c = 32 * wc + 4 * fq, rin0 = wr * 64 + fr;
        const bool lat = u.pm >= 16;
        float* ob = (!lat && u.pn >= 14) ? out + 50331648 + (u.pn - 14) * 256 : nullptr;
        f32x4 cs[4][2];
#pragma unroll
        for (int k = 0; k < 4; ++k) { cs[k][0] = (f32x4){1.f, 0.f, 1.f, 0.f}; cs[k][1] = (f32x4){1.f, 0.f, 1.f, 0.f};
            if (lat) { const int pos = (wc & 1) ? 16 * k + fr : 4 * (u.pm & 3) + 2 * (k & 1) + wr; const float* rp = rope + (size_t)(pos * 48 + 32 + 4 * fq) * 2; cs[k][0] = *(const f32x4*)rp; cs[k][1] = *(const f32x4*)(rp + 4); } }
#pragma unroll
        for (int ai = 0; ai < 2; ++ai)
#pragma unroll
            for (int m = 0; m < 4; ++m) { const int rin = rin0 + ai * HALF + m * 16; bf16_t* rowp = O + (size_t)(u.pm * BM + rin) * 4608 + u.pn * BM + c;
                const f32x4 cs01 = (wc & 1) ? cs[m][0] : cs[ai][0], cs23 = (wc & 1) ? cs[m][1] : cs[ai][1];
#pragma unroll
                for (int bj = 0; bj < 2; ++bj) { const f32x4 x1 = acc[ai][bj][m][0], x2 = acc[ai][bj][m][1];
                    f32x4 y1, y2;
                    y1[0] = x1[0] * cs01[0] - x2[0] * cs01[1]; y2[0] = x2[0] * cs01[0] + x1[0] * cs01[1];
                    y1[1] = x1[1] * cs01[2] - x2[1] * cs01[3]; y2[1] = x2[1] * cs01[2] + x1[1] * cs01[3];
                    y1[2] = x1[2] * cs23[0] - x2[2] * cs23[1]; y2[2] = x2[2] * cs23[0] + x1[2] * cs23[1];
                    y1[3] = x1[3] * cs23[2] - x2[3] * cs23[3]; y2[3] = x2[3] * cs23[2] + x1[3] * cs23[3];
                    u32x2 w1, w2; w1.x = cvt_pk_bf16(y1[0], y1[1]); w1.y = cvt_pk_bf16(y1[2], y1[3]); w2.x = cvt_pk_bf16(y2[0], y2[1]); w2.y = cvt_pk_bf16(y2[2], y2[3]);
                    st8(rowp + bj * HALF, w1); st8(rowp + bj * HALF + 16, w2);
                    if (ob) { float* d = ob + ((size_t)(u.pm * 4 + l) * 256 + rin) * 512 + bj * HALF + c; st16f(d, x1); st16f(d + 16, x2); } } }
    }
};
struct InOrder : StaticOrder {
    __device__ __forceinline__ bool next(int i, Unit& u) const {
        if (!StaticOrder::next(i, u)) return false;
        const int q = u.pm / 3, r = u.pm - 3 * q; u.pm = (r == 0) ? q : 16 + 2 * q + r - 1; return true;
    }
};
struct EpiInAll {
    static constexpr bool AFTER_DRAIN = false; static constexpr int NKIND = 3;
    static __device__ __forceinline__ int kind(const Unit& u) { return (u.pn >= 6 && u.pn <= 10) ? 1 : ((u.pn >= 12 && u.pn <= 15) ? 2 : 0); }
    static __device__ __forceinline__ int browk(int kd, int R) { return kd == 0 ? EpiInP::brow(R) : (kd == 1 ? EpiInG::brow(R) : EpiInD::brow(R)); }
    EpiInP p; EpiInG g; EpiInD d;
    __device__ __forceinline__ void operator()(const f32x4 (&acc)[2][2][4][2], const Unit& u, int wr, int wc, int fr, int fq) const {
        const int kd = kind(u);
        if (kd == 0) p(acc, u, wr, wc, fr, fq); else if (kd == 1) g(acc, u, wr, wc, fr, fq); else d(acc, u, wr, wc, fr, fq);
    }
};
template <int KINDS> struct SubOrder : StaticOrder {
    __host__ __device__ bool next(int i, Unit& u) const { if (!StaticOrder::next(i, u)) return false;
        if (KINDS == 0) u.pn = (u.pn < 6) ? u.pn : (u.pn == 6 ? 11 : u.pn + 9); else if (KINDS == 1) u.pn += 6; else u.pn += 12; return true; }
};

template <class Epi, class Sched, bool ALIGN_EPI = false, bool SP2 = false, int MB = 4>
__device__ __forceinline__ void gemm_phase(PG8_LAS unsigned char* lds, const Gemm g, const Sched& S, const Epi& E) {
    int tid_ = threadIdx.x; asm volatile("" : "+v"(tid_)); const int tid = tid_, wid = __builtin_amdgcn_readfirstlane(tid >> 6), lane = tid & 63, wr = wid >> 2, wc = wid & 3, fr = lane & 15, fq = lane >> 4;
    const int K = g.K;
    constexpr int NK = Epi::NKIND;
    unsigned voffA[2], voffBk[NK][2];
#pragma unroll
    for (int i = 0; i < 2; ++i) { int R, C; stage_rc(tid * 16 + i * 8192, R, C);
        const int Ra = (MB == 4) ? R : (R >> 6) * 48 + ((R & 63) < 48 ? (R & 63) : 47); voffA[i] = (unsigned)(Ra * K + C) * 2u;
#pragma unroll
        for (int kd = 0; kd < NK; ++kd) voffBk[kd][i] = (unsigned)(Epi::browk(kd, R) * K + C) * 2u; }
    const size_t kstep = (size_t)(BK * 2);
    const size_t hstepB = (size_t)HALF * K * 2, hstepA = (size_t)(32 * MB) * K * 2;
    const size_t tstepB = 2 * hstepB, tstepA = 2 * hstepA;
    const unsigned ldsw = (unsigned)wid * 1024u;
    const int aoff = lds_byte(wr * 64 + fr, fq * 8), boff = lds_byte(wc * 32 + fr, fq * 8);
#define PG8_SA(b, h) (((b) * 2 + (h)) * HTB)
#define PG8_SB(b, h) ((4 + (b) * 2 + (h)) * HTB)
#define PG8_STAGE(bufoff, gbase, voff) do { _Pragma("unroll") for (int _i = 0; _i < 2; ++_i) \
        __builtin_amdgcn_global_load_lds((const unsigned*)((const char*)(gbase) + (voff)[_i]), (PG8_LAS unsigned*)(lds + (bufoff) + ldsw + _i * 8192), 16, 0, 0); } while (0)
#define PG8_LDA(dst, b, h) do { _Pragma("unroll") for (int m = 0; m < MB; ++m) _Pragma("unroll") for (int k = 0; k < 2; ++k) dst[m][k] = *(const PG8_LAS bf16x8*)(lds + PG8_SA(b, h) + aoff + m * 2048 + k * 1024); } while (0)
#define PG8_LDB(dst, b, h) do { _Pragma("unroll") for (int n = 0; n < 2; ++n) _Pragma("unroll") for (int k = 0; k < 2; ++k) dst[n][k] = *(const PG8_LAS bf16x8*)(lds + PG8_SB(b, h) + boff + n * 2048 + k * 1024); } while (0)
#define PG8_MMA(ai, bj, At, Bt) do { __builtin_amdgcn_s_setprio(1); _Pragma("unroll") for (int m = 0; m < MB; ++m) _Pragma("unroll") for (int n = 0; n < 2; ++n) _Pragma("unroll") for (int k = 0; k < 2; ++k) \
        acc[ai][bj][m][n] = __builtin_amdgcn_mfma_f32_16x16x32_bf16(Bt[n][k], At[m][k], acc[ai][bj][m][n], 0, 0, 0); __builtin_amdgcn_s_setprio(0); } while (0)
#define PG8_WAIT_V(n) asm volatile("s_waitcnt vmcnt(" #n ")" ::: "memory")
#define PG8_WAIT_L(n) asm volatile("s_waitcnt lgkmcnt(" #n ")" ::: "memory")
#define PG8_BAR __builtin_amdgcn_s_barrier()
#define PG8_SCHED __builtin_amdgcn_sched_barrier(0)
    Unit cur, nxt; int ui = 0;
    if (!S.next(0, cur)) return;
    if (!Sched::SPLITK) { cur.k0 = 0; cur.nt = K / BK; }
    unsigned vbc[2], vbn[2];
#define PG8_SELB(dst, un) do { const int kd_ = Epi::kind(un); _Pragma("unroll") for (int i_ = 0; i_ < 2; ++i_) { unsigned v_ = voffBk[0][i_]; _Pragma("unroll") for (int q_ = 1; q_ < NK; ++q_) v_ = (kd_ == q_) ? voffBk[q_][i_] : v_; dst[i_] = v_; } } while (0)
    PG8_SELB(vbc, cur);
    f32x4 acc[2][2][4][2];
#pragma unroll
    for (int a = 0; a < 2; ++a)
#pragma unroll
        for (int b = 0; b < 2; ++b)
#pragma unroll
            for (int m = 0; m < 4; ++m)
#pragma unroll
                for (int n = 0; n < 2; ++n) acc[a][b][m][n] = (f32x4){0.f, 0.f, 0.f, 0.f};
    bf16x8 At[4][2], B0[2][2], B1[2][2];
    const char* cA = (const char*)g.A + (size_t)cur.pm * tstepA + (size_t)cur.k0 * 2; const char* cB = (const char*)g.Bt + (size_t)cur.pn * tstepB + (size_t)cur.k0 * 2;
    S.a_ready(cur);
    if constexpr (SP2) {
        PG8_STAGE(PG8_SB(0, 0), cB, vbc); PG8_STAGE(PG8_SB(0, 1), cB + hstepB, vbc); PG8_STAGE(PG8_SA(0, 0), cA, voffA); PG8_STAGE(PG8_SA(0, 1), cA + hstepA, voffA);
        if (wr == 1) PG8_BAR;
        PG8_WAIT_V(2); PG8_BAR;
        PG8_STAGE(PG8_SB(1, 0), cB + kstep, vbc); PG8_STAGE(PG8_SA(1, 0), cA + kstep, voffA); PG8_STAGE(PG8_SB(1, 1), cB + hstepB + kstep, vbc);
        PG8_WAIT_V(6); PG8_BAR;
    } else {
        PG8_STAGE(PG8_SB(0, 0), cB, vbc); PG8_STAGE(PG8_SA(0, 0), cA, voffA); PG8_STAGE(PG8_SB(0, 1), cB + hstepB, vbc); PG8_STAGE(PG8_SA(0, 1), cA + hstepA, voffA);
        if (wr == 1) PG8_BAR;
        PG8_WAIT_V(4); PG8_BAR;
        PG8_STAGE(PG8_SB(1, 0), cB + kstep, vbc); PG8_STAGE(PG8_SA(1, 0), cA + kstep, voffA); PG8_STAGE(PG8_SB(1, 1), cB + hstepB + kstep, vbc);
        PG8_WAIT_V(6); PG8_BAR;
    }
    for (;;) {
        const bool has_next = S.next(ui + 1, nxt);
        if (!Sched::SPLITK) { nxt.k0 = 0; nxt.nt = K / BK; }
        const int nt = cur.nt;
        if (has_next) PG8_SELB(vbn, nxt); else { vbn[0] = vbc[0]; vbn[1] = vbc[1]; }
        const char* nA = has_next ? (const char*)g.A + (size_t)nxt.pm * tstepA + (size_t)nxt.k0 * 2 : cA; const char* nB = has_next ? (const char*)g.Bt + (size_t)nxt.pn * tstepB + (size_t)nxt.k0 * 2 : cB;
        for (int t = 0; t < nt; t += 2) {
            const bool last = (t == nt - 2);
            unsigned vbl[2]; vbl[0] = last ? vbn[0] : vbc[0]; vbl[1] = last ? vbn[1] : vbc[1];
            const char* a1 = cA + (size_t)(t + 1) * kstep;
            const char* a2 = last ? nA : cA + (size_t)(t + 2) * kstep; const char* b2 = last ? nB : cB + (size_t)(t + 2) * kstep;
            const char* a3 = a2 + kstep; const char* b3 = b2 + kstep;
            if (last && has_next) S.a_ready(nxt);
            if constexpr (SP2) {
            PG8_LDB(B0, 0, 0); PG8_LDB(B1, 0, 1); PG8_SCHED; PG8_LDA(At, 0, 0); PG8_STAGE(PG8_SA(1, 1), a1 + hstepA, voffA);
            PG8_WAIT_V(8); PG8_WAIT_L(0); PG8_BAR; PG8_MMA(0, 0, At, B0); PG8_MMA(0, 1, At, B1); PG8_BAR; PG8_SCHED;
            PG8_LDA(At, 0, 1); PG8_STAGE(PG8_SB(0, 0), b2, vbl); PG8_STAGE(PG8_SB(0, 1), b2 + hstepB, vbl); PG8_STAGE(PG8_SA(0, 0), a2, voffA);
            PG8_WAIT_V(8); PG8_WAIT_L(0); PG8_BAR; PG8_MMA(1, 0, At, B0); PG8_MMA(1, 1, At, B1); PG8_BAR; PG8_SCHED;
            PG8_LDB(B0, 1, 0); PG8_LDB(B1, 1, 1); PG8_SCHED; PG8_LDA(At, 1, 0); PG8_STAGE(PG8_SA(0, 1), a2 + hstepA, voffA);
            PG8_WAIT_V(8); PG8_WAIT_L(0); PG8_BAR; PG8_MMA(0, 0, At, B0); PG8_MMA(0, 1, At, B1); PG8_BAR; PG8_SCHED;
            PG8_LDA(At, 1, 1); PG8_STAGE(PG8_SB(1, 0), b3, vbl); PG8_STAGE(PG8_SB(1, 1), b3 + hstepB, vbl); PG8_STAGE(PG8_SA(1, 0), a3, voffA);
            PG8_WAIT_V(8); PG8_WAIT_L(0); PG8_BAR; PG8_MMA(1, 0, At, B0); PG8_MMA(1, 1, At, B1); PG8_BAR; PG8_SCHED;
            } else {
            PG8_LDB(B0, 0, 0); PG8_SCHED; PG8_LDA(At, 0, 0); PG8_STAGE(PG8_SA(1, 1), a1 + hstepA, voffA);
            PG8_WAIT_L(8); PG8_BAR; PG8_WAIT_L(0); PG8_MMA(0, 0, At, B0); PG8_BAR; PG8_SCHED;
            PG8_LDB(B1, 0, 1); PG8_STAGE(PG8_SB(0, 0), b2, vbl);
            PG8_BAR; PG8_WAIT_L(0); PG8_MMA(0, 1, At, B1); PG8_BAR;
            PG8_LDA(At, 0, 1); PG8_STAGE(PG8_SA(0, 0), a2, voffA);
            PG8_BAR; PG8_WAIT_L(0); PG8_MMA(1, 0, At, B0); PG8_BAR; PG8_SCHED;
            PG8_STAGE(PG8_SB(0, 1), b2 + hstepB, vbl);
            PG8_WAIT_V(6); PG8_BAR; PG8_MMA(1, 1, At, B1); PG8_BAR;
            PG8_LDB(B0, 1, 0); PG8_SCHED; PG8_LDA(At, 1, 0); PG8_STAGE(PG8_SA(0, 1), a2 + hstepA, voffA);
            PG8_WAIT_L(8); PG8_BAR; PG8_WAIT_L(0); PG8_MMA(0, 0, At, B0); PG8_BAR; PG8_SCHED;
            PG8_LDB(B1, 1, 1); PG8_STAGE(PG8_SB(1, 0), b3, vbl);
            PG8_BAR; PG8_WAIT_L(0); PG8_MMA(0, 1, At, B1); PG8_BAR;
            PG8_LDA(At, 1, 1); PG8_STAGE(PG8_SA(1, 0), a3, voffA);
            PG8_BAR; PG8_WAIT_L(0); PG8_MMA(1, 0, At, B0); PG8_BAR; PG8_SCHED;
            PG8_STAGE(PG8_SB(1, 1), b3 + hstepB, vbl);
            PG8_WAIT_V(6); PG8_BAR; PG8_MMA(1, 1, At, B1); PG8_BAR;
            }
        }
        if constexpr (ALIGN_EPI) { if (wr == 0) PG8_BAR; }
        if constexpr (!Epi::AFTER_DRAIN) { E(acc, cur, wr, wc, fr, fq); S.done(cur); }
        if (!has_next) break;
#pragma unroll
        for (int a = 0; a < 2; ++a)
#pragma unroll
            for (int b = 0; b < 2; ++b)
#pragma unroll
                for (int m = 0; m < 4; ++m)
#pragma unroll
                    for (int n = 0; n < 2; ++n) acc[a][b][m][n] = (f32x4){0.f, 0.f, 0.f, 0.f};
        cur = nxt; cA = nA; cB = nB; ++ui; vbc[0] = vbn[0]; vbc[1] = vbn[1];
        if constexpr (ALIGN_EPI) { if (wr == 1) PG8_BAR; }
    }
    PG8_WAIT_V(0);
    if constexpr (!ALIGN_EPI) { if (wr == 0) PG8_BAR; }
    PG8_BAR;
    if constexpr (Epi::AFTER_DRAIN) { E.fused(acc, cur, wr, wc, fr, fq, lds, wid, lane); S.done(cur); }
#undef PG8_SA
#undef PG8_SB
#undef PG8_STAGE
#undef PG8_LDA
#undef PG8_LDB
#undef PG8_MMA
#undef PG8_WAIT_V
#undef PG8_WAIT_L
#undef PG8_BAR
#undef PG8_SCHED
#undef PG8_SELB
}
}

constexpr int DM = 2048, NCTX = 4096, NLAT = 8192, MTOK = 12288, DEPTH = 4, DIN = 4608, DFF = 8192, NMODW = 12288;
constexpr int CTX_B = 16, CTX_T = 256, LAT_B = 8, LAT_T = 1024, PAST = 256;
constexpr int C_NAQ = 0, C_NAK = 512, C_NAV = 1024, C_GQ = 1536, C_GK = 2560, C_GV = 2816, C_DQ = 3072, C_DK = 3584, C_DV = 4096;
constexpr int AO_NA = 0, AO_G = 512, AO_D = 1536;
constexpr float EPS = 1e-6f;
constexpr size_t OUT_X = 0, OUT_NAK = 25165824, OUT_NAV = OUT_NAK + 8388608, OUT_GK = OUT_NAV + 8388608, OUT_GV = OUT_GK + 4194304, OUT_DK = OUT_GV + 4194304, OUT_DV = OUT_DK + 8388608, OUT_END = OUT_DV + 8388608;
static_assert(OUT_END == 67108864, "out map");
constexpr size_t MiB = 1u << 20;
constexpr size_t WS_CTL = 0, CTL_ZERO_BYTES = 20480;
constexpr size_t WS_MOD = 1 * MiB;
constexpr size_t WS_ROPE = 3 * MiB;
constexpr size_t WS_WIN = 4 * MiB;
constexpr size_t WS_WOUT = 76 * MiB;
constexpr size_t WS_WUP = 108 * MiB;
constexpr size_t WS_WDN = 236 * MiB;
constexpr size_t WS_H = 364 * MiB;
constexpr size_t WS_QKV = 412 * MiB;
constexpr size_t WS_AO = WS_H;
constexpr size_t WS_O2 = WS_QKV;
constexpr size_t WS_O2B = WS_QKV + 48 * MiB;
constexpr size_t WS_XB = 928 * MiB;
constexpr size_t WS_U = 664 * MiB;
constexpr size_t WS_CNAK = 856 * MiB, WS_CNAV = 864 * MiB, WS_CGK = 872 * MiB, WS_CGV = 876 * MiB, WS_CDK = 880 * MiB, WS_CDV = 888 * MiB;
constexpr size_t WS_END = 896 * MiB;
constexpr int CW_BAR = 0;

constexpr int RING_OFF = 0, RING_BYTES = 131072;
constexpr int LDSCTL_OFF = RING_BYTES, MISC_OFF = LDSCTL_OFF + 320;
constexpr int LDS_BYTES = 147456;
constexpr int NWAVES = 8, NTHREADS = 512;

#define GAS __attribute__((address_space(1)))
#define LAS __attribute__((address_space(3)))
typedef unsigned short bf16;
typedef unsigned v4u __attribute__((ext_vector_type(4)));
typedef unsigned v2u __attribute__((ext_vector_type(2)));
typedef float f32x4 __attribute__((ext_vector_type(4)));
typedef float f32x2 __attribute__((ext_vector_type(2)));
#define LDS_WAIT() asm volatile("s_waitcnt lgkmcnt(0)" ::: "memory")
#define VM_WAIT() asm volatile("s_waitcnt vmcnt(0)" ::: "memory")
__device__ __forceinline__ unsigned f2bf(float f) { unsigned u = __builtin_bit_cast(unsigned, f); return (u + 0x7fffu + ((u >> 16) & 1u)) >> 16; }
__device__ __forceinline__ unsigned pk2(float lo, float hi) { unsigned r; asm("v_cvt_pk_bf16_f32 %0, %1, %2" : "=v"(r) : "v"(lo), "v"(hi)); return r; }
__device__ __forceinline__ float bf_lo(unsigned u) { return __builtin_bit_cast(float, u << 16); }
__device__ __forceinline__ float bf_hi(unsigned u) { return __builtin_bit_cast(float, u & 0xffff0000u); }
__device__ __forceinline__ float wave_sum(float v) {
#pragma unroll
    for (int o = 1; o < 64; o <<= 1) v += __shfl_xor(v, o);
    return v;
}
__device__ __forceinline__ float half_sum(float v) {
#pragma unroll
    for (int o = 1; o < 32; o <<= 1) v += __shfl_xor(v, o);
    return v;
}

struct Args { const float* in[22]; float* out; unsigned char* ws; int ph_lo, ph_hi; };
typedef const __attribute__((address_space(4))) Args CArgs;
__device__ __forceinline__ CArgs* args_here() { CArgs* p = (CArgs*)__builtin_amdgcn_kernarg_segment_ptr(); asm volatile("" : "+s"(p)); return p; }
enum { I_XP = 0, I_XS, I_C, I_CNAK, I_CNAV, I_CGK, I_CGV, I_CDK, I_CDV, I_CCTX, I_WADA, I_BADA, I_NORMG, I_WIN, I_WOUT, I_RPB, I_QG, I_KG, I_LAM, I_DG, I_WUP, I_WDN };

#define XB_TMO      128
#define XB_XCNT(j)  (256  + 64 * (j))
#define XB_XSUB(j)  (1280 + 64 * (j))
#define XB_XGEN(j)  (2304 + 64 * (j))
#define XB_TOP      3328
#define XB_TOPGEN   3392
#define XCD_BAR_WORDS 3456
#define XB_SPIN_CAP (1u << 18)

__device__ __forceinline__ unsigned xb_ld(unsigned* p)              { return __hip_atomic_load(p, __ATOMIC_RELAXED, __HIP_MEMORY_SCOPE_AGENT); }
__device__ __forceinline__ unsigned xb_add(unsigned* p, unsigned v) { return __hip_atomic_fetch_add(p, v, __ATOMIC_RELAXED, __HIP_MEMORY_SCOPE_AGENT); }
__device__ __forceinline__ unsigned xb_xcc_id() { return (unsigned)__builtin_amdgcn_s_getreg((3 << 11) | 20) & 0xFu; }
#define XB_SPIN(cond, bar) do { unsigned _sp = 0; while (cond) { __builtin_amdgcn_s_sleep(1); \
    if ((++_sp & 255u) == 0u) { if (xb_ld(&(bar)[XB_TMO])) break; if (_sp > XB_SPIN_CAP) { atomicAdd(&(bar)[XB_TMO], 1u); break; } } } } while (0)

struct XcdBarrier {
    unsigned* bar; unsigned x;
    volatile LAS unsigned* st;
};

__device__ __forceinline__ XcdBarrier xcd_barrier_post(unsigned* bar, volatile LAS unsigned* st) {
    XcdBarrier b; b.bar = bar; b.x = xb_xcc_id(); b.st = st;
    if (threadIdx.x == 0) (void)xb_add(&bar[XB_XCNT(b.x)], 1u);
    return b;
}
__device__ __forceinline__ void xcd_barrier_complete(unsigned* bar, unsigned x, unsigned& nloc, unsigned& nx) {
    const unsigned G = gridDim.x * gridDim.y * gridDim.z;
    unsigned sum, cnt, mine, sp = 0u;
    for (;;) {
        sum = 0u; cnt = 0u; mine = 0u;
#pragma unroll
        for (unsigned j = 0; j < 16; ++j) { const unsigned c = xb_ld(&bar[XB_XCNT(j)]); sum += c; cnt += (c > 0u) ? 1u : 0u; mine = (j == x) ? c : mine; }
        if (sum == G) break;
        __builtin_amdgcn_s_sleep(1);
        if ((++sp & 255u) == 0u) { if (xb_ld(&bar[XB_TMO])) break; if (sp > XB_SPIN_CAP) { atomicAdd(&bar[XB_TMO], 1u); break; } }
    }
    nloc = mine > 0u ? mine : 1u; nx = cnt > 0u ? cnt : 1u;
}

__device__ __forceinline__ void xcd_barrier(const XcdBarrier& b) {
    asm volatile("s_waitcnt vmcnt(0)" ::: "memory");
    __syncthreads();
    if (threadIdx.x == 0) {
        unsigned* bar = b.bar;
        __builtin_amdgcn_s_waitcnt(0);
        unsigned nloc = b.st[0], nx = b.st[1];
        if (nloc == 0u) { xcd_barrier_complete(bar, b.x, nloc, nx); b.st[0] = nloc; b.st[1] = nx; }
        const unsigned old = xb_add(&bar[XB_XSUB(b.x)], 1u);
        const unsigned gen = old / nloc;
        if (old + 1u == (gen + 1u) * nloc) {
            __builtin_amdgcn_fence(__ATOMIC_RELEASE, "agent");
            asm volatile("s_waitcnt vmcnt(0)" ::: "memory");
            const unsigned og = xb_add(&bar[XB_TOP], 1u);
            const unsigned tg = og / nx;
            if (og + 1u == (tg + 1u) * nx) xb_add(&bar[XB_TOPGEN], 1u);
            else XB_SPIN(xb_ld(&bar[XB_TOPGEN]) == tg, bar);
            __builtin_amdgcn_fence(__ATOMIC_ACQUIRE, "agent");
            xb_add(&bar[XB_XGEN(b.x)], 1u);
            asm volatile("s_waitcnt vmcnt(0)" ::: "memory");
        } else {
            XB_SPIN(xb_ld(&bar[XB_XGEN(b.x)]) == gen, bar);
            __builtin_amdgcn_fence(__ATOMIC_ACQUIRE, "agent");
            asm volatile("s_waitcnt vmcnt(0)" ::: "memory");
        }
    }
    __syncthreads();
}
struct Ctx { LAS unsigned char* lds; int tid, lane, wave, vcu, G, gw, NGW; };

constexpr int CV_IN = (DM / 64) * (DIN / 32), CV_OUT = (DM / 64) * (DM / 32), CV_UP = (DM / 64) * (DFF / 32), CV_DN = (DFF / 64) * (DM / 32), CV_PER_L = CV_IN + CV_OUT + CV_UP + CV_DN;
__device__ __forceinline__ void conv_locate(CArgs* a, int it, const float*& Wt, bf16*& WTt, int& K, int& N) {
    unsigned char* ws = a->ws; const int l = it / CV_PER_L; int r = it % CV_PER_L; const float* W; bf16* WT;
    if (r < CV_IN) { W = a->in[I_WIN] + (size_t)l * DM * DIN; WT = (bf16*)(ws + WS_WIN) + (size_t)l * DIN * DM; K = DM; N = DIN; }
    else if (r < CV_IN + CV_OUT) { r -= CV_IN; W = a->in[I_WOUT] + (size_t)l * DM * DM; WT = (bf16*)(ws + WS_WOUT) + (size_t)l * DM * DM; K = DM; N = DM; }
    else if (r < CV_IN + CV_OUT + CV_UP) { r -= CV_IN + CV_OUT; W = a->in[I_WUP] + (size_t)l * DM * DFF; WT = (bf16*)(ws + WS_WUP) + (size_t)l * DFF * DM; K = DM; N = DFF; }
    else { r -= CV_IN + CV_OUT + CV_UP; W = a->in[I_WDN] + (size_t)l * DFF * DM; WT = (bf16*)(ws + WS_WDN) + (size_t)l * DM * DFF; K = DFF; N = DM; }
    const int nblk = N / 32, kb = r / nblk, nb = r - kb * nblk;
    Wt = W + (size_t)(64 * kb) * N + 32 * nb; WTt = WT + (size_t)(32 * nb) * K + 64 * kb;
}
#define CONV_LOAD(Wt, N) do { const float* s_ = (Wt) + (size_t)(lane >> 3) * (N) + 4 * (lane & 7); _Pragma("unroll") for (int i = 0; i < 8; ++i) w[i] = __builtin_nontemporal_load((const f32x4*)(s_ + (size_t)(8 * i) * (N))); } while (0)
__device__ __forceinline__ void conv_all(CArgs* a, LAS float* scr, int it, int step, int lane) {
    constexpr int TOT = DEPTH * CV_PER_L;
    f32x4 w[8]; const float* Wt; bf16* WTt; int K, N;
    if (it < TOT) { conv_locate(a, it, Wt, WTt, K, N); CONV_LOAD(Wt, N); }
    while (it < TOT) {
        { LAS float* d = scr + (lane >> 3) * 33 + 4 * (lane & 7);
#pragma unroll
          for (int i = 0; i < 8; ++i) { d[i * 8 * 33 + 0] = w[i].x; d[i * 8 * 33 + 1] = w[i].y; d[i * 8 * 33 + 2] = w[i].z; d[i * 8 * 33 + 3] = w[i].w; } }
        bf16* const WTc = WTt; const int Kc = K;
        it += step;
        if (it < TOT) { conv_locate(a, it, Wt, WTt, K, N); CONV_LOAD(Wt, N); }
        asm volatile("" ::: "memory");
        const int c = lane & 7;
#pragma unroll
        for (int j = 0; j < 4; ++j) { const int n = (lane >> 3) + 8 * j; const LAS float* s = scr + (8 * c) * 33 + n;
            v4u o; o.x = pk2(s[0 * 33], s[1 * 33]); o.y = pk2(s[2 * 33], s[3 * 33]); o.z = pk2(s[4 * 33], s[5 * 33]); o.w = pk2(s[6 * 33], s[7 * 33]);
            *(GAS v4u*)(WTc + (size_t)n * Kc + 8 * c) = o; }
        LDS_WAIT(); asm volatile("" ::: "memory");
    }
}

__device__ __forceinline__ void cvt_tensor(const float* src, bf16* dst, size_t n8, size_t gt, size_t NT) {
    for (size_t i = gt; i < n8; i += 4 * NT) { f32x4 a[4], b[4];
#pragma unroll
        for (int u = 0; u < 4; ++u) if (i + u * NT < n8) { a[u] = __builtin_nontemporal_load((const f32x4*)(src + (i + u * NT) * 8)); b[u] = __builtin_nontemporal_load((const f32x4*)(src + (i + u * NT) * 8 + 4)); }
#pragma unroll
        for (int u = 0; u < 4; ++u) if (i + u * NT < n8) { v4u o; o.x = pk2(a[u].x, a[u].y); o.y = pk2(a[u].z, a[u].w); o.z = pk2(b[u].x, b[u].y); o.w = pk2(b[u].z, b[u].w); *(v4u*)(dst + (i + u * NT) * 8) = o; } }
}

#ifndef PROBE_SITE
#define PROBE_SITE -1
#endif
#define PP0(n) do { if (PROBE_SITE == (n)) tp_ = __builtin_amdgcn_s_memrealtime(); } while (0)
#define PP1(n) do { if (PROBE_SITE == (n)) pacc += (__builtin_amdgcn_s_memrealtime() - tp_) * 4; } while (0)
__device__ __forceinline__ void ph_prologue(CArgs* a, const Ctx& X, unsigned long long& pacc) {
    unsigned char* ws = a->ws; unsigned long long tp_ = 0;
#ifndef PROMASK
#define PROMASK 15
#endif
    PP0(20);
    if (PROMASK & 1)
    {
        constexpr int SLW = 2176;
        LAS float* sl = (LAS float*)X.lds; LAS float* red = (LAS float*)(X.lds + 9 * SLW * 4);
        const float* cin = a->in[I_C]; const float* cctx = a->in[I_CCTX];
        for (int i = X.tid; i < 9 * 2048; i += NTHREADS) { const int v = i >> 11, k = i & 2047; const float x = (v < 8) ? cin[v * 2048 + k] : cctx[k];
            sl[v * SLW + k + 4 * (k >> 6)] = x / (1.0f + expf(-x)); }
        __syncthreads();
        float* mod = (float*)(ws + WS_MOD); const float* wada = a->in[I_WADA]; const float* bada = a->in[I_BADA];
        const int kq = X.tid >> 4, cg = X.tid & 15, k0 = kq * 64;
        for (int item = X.vcu; item < DEPTH * 192; item += X.G) {
            const int l = item / 192, n0 = (item % 192) * 64;
            const float* W = wada + (size_t)l * DM * NMODW + n0 + 4 * cg;
            f32x4 acc[9];
#pragma unroll
            for (int v = 0; v < 9; ++v) acc[v] = (f32x4){0.f, 0.f, 0.f, 0.f};
            const float* Wp = W + (size_t)k0 * NMODW;
#pragma unroll 1
            for (int kk = 0; kk < 64; kk += 8) {
                f32x4 w[8];
#pragma unroll
                for (int i = 0; i < 8; ++i) w[i] = __builtin_nontemporal_load((const f32x4*)(Wp + (size_t)i * NMODW));
                Wp += (size_t)8 * NMODW;
#pragma unroll
                for (int v = 0; v < 9; ++v) { const f32x4 s0 = *(const LAS f32x4*)(sl + v * SLW + k0 + kk + 4 * kq), s1 = *(const LAS f32x4*)(sl + v * SLW + k0 + kk + 4 + 4 * kq);
                    acc[v] += w[0] * s0.x + w[1] * s0.y + w[2] * s0.z + w[3] * s0.w + w[4] * s1.x + w[5] * s1.y + w[6] * s1.z + w[7] * s1.w; }
            }
#pragma unroll
            for (int v = 0; v < 9; ++v)
#pragma unroll
                for (int j = 0; j < 4; ++j) { float t = acc[v][j]; t += __shfl_xor(t, 16); t += __shfl_xor(t, 32); acc[v][j] = t; }
            if (X.lane < 16) {
#pragma unroll
                for (int v = 0; v < 9; ++v) *(LAS f32x4*)(red + (X.wave * 9 + v) * 64 + 4 * X.lane) = acc[v];
            }
            __syncthreads();
            for (int o = X.tid; o < 576; o += NTHREADS) { const int v = o >> 6, cc = o & 63; float s = 0.f;
#pragma unroll
                for (int w = 0; w < 8; ++w) s += red[(w * 9 + v) * 64 + cc];
                mod[(size_t)(l * 9 + v) * NMODW + n0 + cc] = s + bada[l * NMODW + n0 + cc]; }
            __syncthreads();
        }
    }
    PP1(20); PP0(21);
    if (PROMASK & 2)
    {
        LAS float* scr = (LAS float*)(X.lds + RING_OFF + X.wave * 16384);
        conv_all(a, scr, X.gw, X.NGW, X.lane);
    }
    PP1(21); PP0(22);
    if (PROMASK & 4)
    {
        f32x2* rope = (f32x2*)(ws + WS_ROPE);
        for (int i = X.vcu * NTHREADS + X.tid; i < 64 * 48; i += X.G * NTHREADS) { const int pos = i / 48, f = i % 48;
            const double e = (f < 32) ? (double)f / 32.0 : (double)(f - 32) / 16.0;
            const float inv = (float)exp(-9.210340371976184 * e); const float ang = (float)pos * inv;
            const double ad = (double)ang; const double nq = __builtin_rint(ad * 0.6366197723675814); const double r = ad - nq * 1.5707963267948966, r2 = r * r;
            const double sr = r * (1.0 + r2 * (-1.0 / 6 + r2 * (1.0 / 120 + r2 * (-1.0 / 5040 + r2 * (1.0 / 362880 + r2 * (-1.0 / 39916800 + r2 * (1.0 / 6227020800.0)))))));
            const double cr = 1.0 + r2 * (-0.5 + r2 * (1.0 / 24 + r2 * (-1.0 / 720 + r2 * (1.0 / 40320 + r2 * (-1.0 / 3628800 + r2 * (1.0 / 479001600 + r2 * (-1.0 / 87178291200.0)))))));
            const int q = ((int)nq) & 3;
            const double cv = (q == 0) ? cr : (q == 1) ? -sr : (q == 2) ? -cr : sr, sv = (q == 0) ? sr : (q == 1) ? cr : (q == 2) ? -sr : -cr;
            rope[i] = (f32x2){(float)cv, (float)sv}; }
    }
    PP1(22); PP0(23);
    if (PROMASK & 8)
    {
        const size_t gt = (size_t)X.vcu * NTHREADS + X.tid, NT = (size_t)X.G * NTHREADS;
        cvt_tensor(a->in[I_CNAK], (bf16*)(ws + WS_CNAK), (size_t)LAT_B * DEPTH * PAST * 512 / 8, gt, NT);
        cvt_tensor(a->in[I_CNAV], (bf16*)(ws + WS_CNAV), (size_t)LAT_B * DEPTH * PAST * 512 / 8, gt, NT);
        cvt_tensor(a->in[I_CGK], (bf16*)(ws + WS_CGK), (size_t)LAT_B * DEPTH * PAST * 256 / 8, gt, NT);
        cvt_tensor(a->in[I_CGV], (bf16*)(ws + WS_CGV), (size_t)LAT_B * DEPTH * PAST * 256 / 8, gt, NT);
        cvt_tensor(a->in[I_CDK], (bf16*)(ws + WS_CDK), (size_t)LAT_B * DEPTH * PAST * 512 / 8, gt, NT);
        cvt_tensor(a->in[I_CDV], (bf16*)(ws + WS_CDV), (size_t)LAT_B * DEPTH * PAST * 512 / 8, gt, NT);
    }
    PP1(23);
}

__device__ __forceinline__ int mod_vec(int m) { return m < NCTX ? 8 : ((m - NCTX) >> 10); }

__device__ __forceinline__ f32x4 ld_bf4(const bf16* p) { const v2u w = *(const v2u*)p; return (f32x4){bf_lo(w.x), bf_hi(w.x), bf_lo(w.y), bf_hi(w.y)}; }
__device__ __forceinline__ float sumsq4(f32x4 v) { return (v.x * v.x + v.y * v.y) + (v.z * v.z + v.w * v.w); }
template <bool FIRST, bool LAST>
__device__ __forceinline__ void norm_rows(CArgs* a, const Ctx& X, const bf16* o2, const float* g_post, const float* mod_gate, int gate_off,
                                          const float* g_pre, const float* mod_next, int sh_off, int sc_off) {
    bf16* XB = (bf16*)(a->ws + WS_XB); bf16* H = (bf16*)(a->ws + WS_H); const bf16* O2B = (const bf16*)(a->ws + WS_O2B);
    const int lc = 4 * X.lane;
    const int chunk = (MTOK + X.NGW - 1) / X.NGW, mbeg = X.gw * chunk, mend = (mbeg + chunk < MTOK) ? mbeg + chunk : MTOK;
    LAS f32x4* prm = (LAS f32x4*)X.lds;
    const int bfirst = X.vcu * NWAVES * chunk, blast = (bfirst + NWAVES * chunk - 1 < MTOK - 1) ? bfirst + NWAVES * chunk - 1 : MTOK - 1;
    const int mvA = mod_vec(bfirst < MTOK ? bfirst : MTOK - 1), mvB = mod_vec(blast);
    for (int i = X.tid; i < 1024; i += NTHREADS) { const int st = i >> 9, c4 = i & 511, col = 4 * c4, mv = st ? mvB : mvA;
        if (!FIRST) prm[(st * 3 + 0) * 512 + c4] = *(const f32x4*)(g_post + col) * *(const f32x4*)(mod_gate + (size_t)mv * NMODW + gate_off + col);
        if (!LAST) { prm[(st * 3 + 1) * 512 + c4] = *(const f32x4*)(g_pre + col) * (*(const f32x4*)(mod_next + (size_t)mv * NMODW + sc_off + col) + 1.0f);
                     prm[(st * 3 + 2) * 512 + c4] = *(const f32x4*)(mod_next + (size_t)mv * NMODW + sh_off + col); } }
    __syncthreads();
    f32x4 nxf[FIRST ? 8 : 1]; v2u nx[FIRST ? 1 : 8], no[FIRST ? 1 : 8], nb[FIRST ? 1 : 8];
#define NORM_LOAD_ROW(mm) do { const int m_ = (mm); \
        if (FIRST) { const float* src_ = (m_ < NCTX) ? a->in[I_XP] + (size_t)m_ * DM : a->in[I_XS] + (size_t)(m_ - NCTX) * DM; \
            _Pragma("unroll") for (int j = 0; j < 8; ++j) nxf[FIRST ? j : 0] = *(const f32x4*)(src_ + lc + 256 * j); } \
        else { _Pragma("unroll") for (int j = 0; j < 8; ++j) { nx[FIRST ? 0 : j] = *(const v2u*)(XB + (size_t)m_ * DM + lc + 256 * j); no[FIRST ? 0 : j] = *(const v2u*)(o2 + (size_t)m_ * DM + lc + 256 * j); } \
            if (m_ >= 8192) { _Pragma("unroll") for (int j = 0; j < 8; ++j) nb[FIRST ? 0 : j] = *(const v2u*)(O2B + (size_t)(m_ - 8192) * DM + lc + 256 * j); } } } while (0)
#define BF4(w) ((f32x4){bf_lo((w).x), bf_hi((w).x), bf_lo((w).y), bf_hi((w).y)})
    if (mbeg < mend) NORM_LOAD_ROW(mbeg);
    for (int m = mbeg; m < mend; ++m) {
        const LAS f32x4* ps = prm + ((mod_vec(m) == mvA) ? 0 : 3 * 512) + X.lane;
        f32x4 x[8]; f32x4 o[FIRST ? 1 : 8];
        if (FIRST) {
#pragma unroll
            for (int j = 0; j < 8; ++j) x[j] = nxf[FIRST ? j : 0];
        } else {
#pragma unroll
            for (int j = 0; j < 8; ++j) { x[j] = BF4(nx[FIRST ? 0 : j]); o[FIRST ? 0 : j] = BF4(no[FIRST ? 0 : j]); }
            if (m >= 8192) {
#pragma unroll
                for (int j = 0; j < 8; ++j) o[FIRST ? 0 : j] += BF4(nb[FIRST ? 0 : j]); }
        }
        if (m + 1 < mend) NORM_LOAD_ROW(m + 1);
        if (!FIRST) {
            float ss = 0.f;
#pragma unroll
            for (int j = 0; j < 8; ++j) ss += sumsq4(o[FIRST ? 0 : j]);
            const float r1 = 1.0f / sqrtf(wave_sum(ss) * (1.0f / DM) + EPS);
#pragma unroll
            for (int j = 0; j < 8; ++j) x[j] = x[j] + (o[FIRST ? 0 : j] * r1) * ps[0 * 512 + 64 * j];
        }
        if (LAST) {
#pragma unroll
            for (int j = 0; j < 8; ++j) __builtin_nontemporal_store(x[j], (f32x4*)(a->out + (size_t)m * DM + lc + 256 * j));
        } else {
            float ss = 0.f;
#pragma unroll
            for (int j = 0; j < 8; ++j) { ss += sumsq4(x[j]); v2u w; w.x = pk2(x[j].x, x[j].y); w.y = pk2(x[j].z, x[j].w); *(v2u*)(XB + (size_t)m * DM + lc + 256 * j) = w; }
            const float r2 = 1.0f / sqrtf(wave_sum(ss) * (1.0f / DM) + EPS);
#pragma unroll
            for (int j = 0; j < 8; ++j) { const f32x4 h = (x[j] * r2) * ps[1 * 512 + 64 * j] + ps[2 * 512 + 64 * j];
                v2u w; w.x = pk2(h.x, h.y); w.y = pk2(h.z, h.w); *(v2u*)(H + (size_t)m * DM + lc + 256 * j) = w; }
        }
    }
    __syncthreads();
}
#undef NORM_LOAD_ROW
#undef BF4
__device__ __forceinline__ void ph_fixup(CArgs* a, const Ctx& X, int l) {
    bf16* QKV = (bf16*)(a->ws + WS_QKV); const f32x2* rope = (const f32x2*)(a->ws + WS_ROPE);
    const int lane = X.lane;
    const float qg0 = a->in[I_QG][l * 128 + 2 * lane], qg1 = a->in[I_QG][l * 128 + 2 * lane + 1];
    const float kg0 = a->in[I_KG][l * 128 + 2 * lane], kg1 = a->in[I_KG][l * 128 + 2 * lane + 1];
    float* out = a->out;
    for (int m = X.gw; m < MTOK; m += X.NGW) {
        bf16* row = QKV + (size_t)m * DIN + 2 * lane;
        const bool lat = m >= NCTX; const int t = (m - NCTX) & 1023, prow = t >> 6, pcol = t & 63;
        const int cb = m >> 8, ct = m & 255;
        unsigned ug[10];
#pragma unroll
        for (int hh = 0; hh < 10; ++hh) ug[hh] = *(const unsigned*)(row + (hh < 8 ? C_GQ + hh * 128 : C_GK + (hh - 8) * 128));
        if (lat) {
            unsigned ud[8];
#pragma unroll
            for (int hh = 0; hh < 8; ++hh) ud[hh] = *(const unsigned*)(row + (hh < 4 ? C_DQ + hh * 128 : C_DK + (hh - 4) * 128));
            const int posg = (lane < 32) ? prow : pcol, fig = (2 * lane) & 31; const f32x2 g0 = rope[posg * 48 + fig], g1 = rope[posg * 48 + fig + 1]; const float sgg = (lane & 16) ? 1.0f : -1.0f;
            const int posd = (lane & 16) ? pcol : prow, fid = 32 + ((2 * lane) & 15); const f32x2 d0 = rope[posd * 48 + fid], d1 = rope[posd * 48 + fid + 1]; const float sgd = (lane & 8) ? 1.0f : -1.0f;
            float ss[10];
#pragma unroll
            for (int hh = 0; hh < 10; ++hh) { const float x0 = bf_lo(ug[hh]), x1 = bf_hi(ug[hh]); ss[hh] = x0 * x0 + x1 * x1; }
#pragma unroll
            for (int o = 1; o < 64; o <<= 1)
#pragma unroll
                for (int hh = 0; hh < 10; ++hh) ss[hh] += __shfl_xor(ss[hh], o);
#pragma unroll
            for (int hh = 0; hh < 10; ++hh) { const float r = 1.0f / sqrtf(ss[hh] * (1.0f / 128.0f) + EPS);
                float x0 = bf_lo(ug[hh]) * r * (hh < 8 ? qg0 : kg0), x1 = bf_hi(ug[hh]) * r * (hh < 8 ? qg1 : kg1);
                const float p0 = __shfl_xor(x0, 16), p1 = __shfl_xor(x1, 16);
                x0 = x0 * g0.x + sgg * p0 * g0.y; x1 = x1 * g1.x + sgg * p1 * g1.y;
                *(unsigned*)(row + (hh < 8 ? C_GQ + hh * 128 : C_GK + (hh - 8) * 128)) = pk2(x0, x1); }
#pragma unroll
            for (int hh = 0; hh < 8; ++hh) { float x0 = bf_lo(ud[hh]), x1 = bf_hi(ud[hh]);
                const float p0 = __shfl_xor(x0, 8), p1 = __shfl_xor(x1, 8);
                x0 = x0 * d0.x + sgd * p0 * d0.y; x1 = x1 * d1.x + sgd * p1 * d1.y;
                *(unsigned*)(row + (hh < 4 ? C_DQ + hh * 128 : C_DK + (hh - 4) * 128)) = pk2(x0, x1); }
        } else {
            unsigned un[18];
#pragma unroll
            for (int j = 0; j < 4; ++j) { un[j] = *(const unsigned*)(row + C_NAK + j * 128); un[4 + j] = *(const unsigned*)(row + C_NAV + j * 128); un[8 + j] = *(const unsigned*)(row + C_DK + j * 128); un[12 + j] = *(const unsigned*)(row + C_DV + j * 128); }
            un[16] = *(const unsigned*)(row + C_GV); un[17] = *(const unsigned*)(row + C_GV + 128);
            float ss[10];
#pragma unroll
            for (int hh = 0; hh < 10; ++hh) { const float x0 = bf_lo(ug[hh]), x1 = bf_hi(ug[hh]); ss[hh] = x0 * x0 + x1 * x1; }
#pragma unroll
            for (int o = 1; o < 64; o <<= 1)
#pragma unroll
                for (int hh = 0; hh < 10; ++hh) ss[hh] += __shfl_xor(ss[hh], o);
            const size_t r5 = ((size_t)(cb * DEPTH + l) * CTX_T + ct) * 512 + 2 * lane, r2 = ((size_t)(cb * DEPTH + l) * CTX_T + ct) * 256 + 2 * lane;
#pragma unroll
            for (int hh = 0; hh < 10; ++hh) { const float r = 1.0f / sqrtf(ss[hh] * (1.0f / 128.0f) + EPS);
                const float x0 = bf_lo(ug[hh]) * r * (hh < 8 ? qg0 : kg0), x1 = bf_hi(ug[hh]) * r * (hh < 8 ? qg1 : kg1);
                *(unsigned*)(row + (hh < 8 ? C_GQ + hh * 128 : C_GK + (hh - 8) * 128)) = pk2(x0, x1);
                if (hh >= 8) *(f32x2*)(out + OUT_GK + r2 + (hh - 8) * 128) = (f32x2){x0, x1}; }
#pragma unroll
            for (int j = 0; j < 4; ++j) {
                *(f32x2*)(out + OUT_NAK + r5 + j * 128) = (f32x2){bf_lo(un[j]), bf_hi(un[j])};
                *(f32x2*)(out + OUT_NAV + r5 + j * 128) = (f32x2){bf_lo(un[4 + j]), bf_hi(un[4 + j])};
                *(f32x2*)(out + OUT_DK + r5 + j * 128) = (f32x2){bf_lo(un[8 + j]), bf_hi(un[8 + j])};
                *(f32x2*)(out + OUT_DV + r5 + j * 128) = (f32x2){bf_lo(un[12 + j]), bf_hi(un[12 + j])}; }
            *(f32x2*)(out + OUT_GV + r2) = (f32x2){bf_lo(un[16]), bf_hi(un[16])}; *(f32x2*)(out + OUT_GV + r2 + 128) = (f32x2){bf_lo(un[17]), bf_hi(un[17])};
        }
    }
}

__device__ __forceinline__ float lambda_init_of(int l) { return 0.8f - 0.6f * expf(-0.3f * (float)l); }

struct SmState { float m, l, o0, o1; };
__device__ __forceinline__ void sm_step(SmState& S, float s, float v0, float v1) {
    const float mn = fmaxf(S.m, s), al = __expf(S.m - mn), p = __expf(s - mn);
    S.l = S.l * al + p; S.o0 = S.o0 * al + p * v0; S.o1 = S.o1 * al + p * v1; S.m = mn;
}
__device__ __forceinline__ void ph_attn_naive(CArgs* a, const Ctx& X, int l) {
    const bf16* QKV = (const bf16*)(a->ws + WS_QKV); bf16* AO = (bf16*)(a->ws + WS_AO);
    const int lane = X.lane;
    const float li = lambda_init_of(l);
    const float* lamv = a->in[I_LAM] + l * 256;
    const float lam = expf(wave_sum(lamv[lane] * lamv[64 + lane])) - expf(wave_sum(lamv[128 + lane] * lamv[192 + lane])) + li;
    const float dg0 = a->in[I_DG][l * 128 + 2 * lane], dg1 = a->in[I_DG][l * 128 + 2 * lane + 1];
    for (int item = X.gw; item < MTOK * 16; item += X.NGW) {
        const int m = item >> 4, hu = item & 15; const bool lat = m >= NCTX;
        const bf16* qrow = QKV + (size_t)m * DIN;
        if (hu < 12) {
            int qc, kc, vc, ocol, cw, ch; const bf16 *ck, *cv;
            if (hu < 4) { qc = C_NAQ + hu * 128; kc = C_NAK + hu * 128; vc = C_NAV + hu * 128; ocol = AO_NA + hu * 128; cw = 512; ch = hu; ck = (const bf16*)(a->ws + WS_CNAK); cv = (const bf16*)(a->ws + WS_CNAV); }
            else { const int hq = hu - 4, kvh = hq >> 2; qc = C_GQ + hq * 128; kc = C_GK + kvh * 128; vc = C_GV + kvh * 128; ocol = AO_G + hq * 128; cw = 256; ch = kvh; ck = (const bf16*)(a->ws + WS_CGK); cv = (const bf16*)(a->ws + WS_CGV); }
            const unsigned uq = *(const unsigned*)(qrow + qc + 2 * lane); const float q0 = bf_lo(uq), q1 = bf_hi(uq);
            const float scale = 0.08838834764831845f;
            SmState S{-1e30f, 0.f, 0.f, 0.f};
            if (!lat) { const int b = m >> 8;
                for (int s = 0; s < CTX_T; ++s) { const bf16* kr = QKV + (size_t)(b * CTX_T + s) * DIN;
                    const unsigned uk = *(const unsigned*)(kr + kc + 2 * lane), uv = *(const unsigned*)(kr + vc + 2 * lane);
                    const float sc = wave_sum(q0 * bf_lo(uk) + q1 * bf_hi(uk)) * scale; sm_step(S, sc, bf_lo(uv), bf_hi(uv)); }
            } else { const int b = (m - NCTX) >> 10, t = (m - NCTX) & 1023;
                if (hu < 4) { const int rq = t >> 6, cq = t & 63; const int r0 = min(max(rq - 4, 0), 8), w0 = min(max(cq - 8, 0), 48);
                    const float* rpb = a->in[I_RPB] + (size_t)(l * 4 + hu) * 15 * 31;
                    for (int rk = r0; rk < r0 + 8; ++rk) for (int ckk = w0; ckk < w0 + 16; ++ckk) {
                        const bf16* kr = QKV + (size_t)(NCTX + b * LAT_T + rk * 64 + ckk) * DIN;
                        const unsigned uk = *(const unsigned*)(kr + kc + 2 * lane), uv = *(const unsigned*)(kr + vc + 2 * lane);
                        const float sc = wave_sum(q0 * bf_lo(uk) + q1 * bf_hi(uk)) * scale + rpb[(rk - rq + 7) * 31 + (ckk - cq + 15)]; sm_step(S, sc, bf_lo(uv), bf_hi(uv)); }
                } else {
                    for (int s = 0; s < LAT_T; ++s) { const bf16* kr = QKV + (size_t)(NCTX + b * LAT_T + s) * DIN;
                        const unsigned uk = *(const unsigned*)(kr + kc + 2 * lane), uv = *(const unsigned*)(kr + vc + 2 * lane);
                        const float sc = wave_sum(q0 * bf_lo(uk) + q1 * bf_hi(uk)) * scale; sm_step(S, sc, bf_lo(uv), bf_hi(uv)); }
                }
                for (int s = 0; s < PAST; ++s) { const size_t off = ((size_t)(b * DEPTH + l) * PAST + s) * cw + ch * 128 + 2 * lane;
                    const unsigned uk = *(const unsigned*)(ck + off), uv = *(const unsigned*)(cv + off);
                    const float sc = wave_sum(q0 * bf_lo(uk) + q1 * bf_hi(uk)) * scale; sm_step(S, sc, bf_lo(uv), bf_hi(uv)); }
            }
            const float inv = 1.0f / S.l;
            *(unsigned*)(AO + (size_t)m * DM + ocol + 2 * lane) = pk2(S.o0 * inv, S.o1 * inv);
        } else {
            const int h = hu - 12, qc = C_DQ + h * 128, kc = C_DK + h * 128, vc = C_DV + h * 128;
            const unsigned uq = *(const unsigned*)(qrow + qc + 2 * lane); const float q0 = bf_lo(uq), q1 = bf_hi(uq);
            const float scale = 0.125f;
            float mm = -1e30f, ll = 0.f;
            float a0 = 0.f, a1 = 0.f, b0 = 0.f, b1 = 0.f;
#define DIFF_STEP(uk, uv) do { const float sc = half_sum(q0 * bf_lo(uk) + q1 * bf_hi(uk)) * scale; const float mn = fmaxf(mm, sc), al = __expf(mm - mn), p = __expf(sc - mn); \
            ll = ll * al + p; mm = mn; const float al0 = __shfl(al, 0), al1 = __shfl(al, 32), p0 = __shfl(p, 0), p1 = __shfl(p, 32); const float v0 = bf_lo(uv), v1 = bf_hi(uv); \
            a0 = a0 * al0 + p0 * v0; a1 = a1 * al0 + p0 * v1; b0 = b0 * al1 + p1 * v0; b1 = b1 * al1 + p1 * v1; } while (0)
            if (!lat) { const int b = m >> 8;
                for (int s = 0; s < CTX_T; ++s) { const bf16* kr = QKV + (size_t)(b * CTX_T + s) * DIN;
                    const unsigned uk = *(const unsigned*)(kr + kc + 2 * lane), uv = *(const unsigned*)(kr + vc + 2 * lane); DIFF_STEP(uk, uv); }
            } else { const int b = (m - NCTX) >> 10;
                for (int s = 0; s < LAT_T; ++s) { const bf16* kr = QKV + (size_t)(NCTX + b * LAT_T + s) * DIN;
                    const unsigned uk = *(const unsigned*)(kr + kc + 2 * lane), uv = *(const unsigned*)(kr + vc + 2 * lane); DIFF_STEP(uk, uv); }
                const bf16* ck = (const bf16*)(a->ws + WS_CDK); const bf16* cv = (const bf16*)(a->ws + WS_CDV);
                for (int s = 0; s < PAST; ++s) { const size_t off = ((size_t)(b * DEPTH + l) * PAST + s) * 512 + h * 128 + 2 * lane;
                    const unsigned uk = *(const unsigned*)(ck + off), uv = *(const unsigned*)(cv + off); DIFF_STEP(uk, uv); }
            }
#undef DIFF_STEP
            const float l0 = __shfl(ll, 0), l1 = __shfl(ll, 32);
            float o0 = a0 / l0 - lam * (b0 / l1), o1 = a1 / l0 - lam * (b1 / l1);
            const float r = 1.0f / sqrtf(wave_sum(o0 * o0 + o1 * o1) * (1.0f / 128.0f) + EPS);
            o0 = o0 * r * dg0 * (1.0f - li); o1 = o1 * r * dg1 * (1.0f - li);
            *(unsigned*)(AO + (size_t)m * DM + AO_D + h * 128 + 2 * lane) = pk2(o0, o1);
        }
    }
}

namespace att {
using bf16x8 = __attribute__((ext_vector_type(8))) short;
using s16x4  = __attribute__((ext_vector_type(4))) short;
using f32x16 = __attribute__((ext_vector_type(16))) float;
constexpr int QBLK = 32, KVBLK = 64, NW = 8;
constexpr int SHM_V = KVBLK * 128 * 2, SHM_K = KVBLK * 128 * 2;
constexpr int OFF_WS = 2 * SHM_V + 2 * SHM_K, OFF_BT = OFF_WS + NW * 64 * 4, OFF_Q = OFF_BT + 576 * 4, ATT_LDS = OFF_Q + 64;
constexpr float THR = 8.f;
#define KSWZ(row, colB) ((row) * 256 + ((colB) ^ (((row) & 15) << 4)))
#define SBAR() __builtin_amdgcn_sched_barrier(0)
__device__ __forceinline__ int crow(int r, int hi) { return (r & 3) + 8 * (r >> 2) + 4 * hi; }
__device__ __forceinline__ unsigned cvtpk(float lo, float hi) { unsigned r; asm volatile("v_cvt_pk_bf16_f32 %0, %1, %2" : "=v"(r) : "v"(lo), "v"(hi)); return r; }

template <int KIND> struct Sc { static constexpr float SCALE = (KIND == 2) ? 0.125f : 0.08838834764831845f; };

template <int KIND>
__device__ __forceinline__ void partialSM(f32x16& p0, f32x16& p1, float& m_reg, float& mn, float& alpha) {
  constexpr float SCALE = Sc<KIND>::SCALE, C = SCALE * 1.4426950408889634f;
  float pmax = p0[0];
#pragma unroll
  for (int r = 1; r < 16; ++r) pmax = fmaxf(pmax, p0[r]);
#pragma unroll
  for (int r = 0; r < 16; ++r) pmax = fmaxf(pmax, p1[r]);
  { auto rr = __builtin_amdgcn_permlane32_swap(__float_as_uint(pmax), __float_as_uint(pmax), false, false);
    pmax = fmaxf(__uint_as_float(rr[0]), __uint_as_float(rr[1])); }
  if (__builtin_expect(__all(pmax - m_reg <= THR / SCALE), 1)) { mn = m_reg; alpha = 1.f; }
  else { mn = fmaxf(m_reg, pmax); alpha = __builtin_amdgcn_exp2f((m_reg - mn) * C); m_reg = mn; }
  float mnC = -mn * C;
#pragma unroll
  for (int r = 0; r < 16; ++r) p0[r] = fmaf(p0[r], C, mnC);
#pragma unroll
  for (int r = 0; r < 16; ++r) p1[r] = fmaf(p1[r], C, mnC);
#pragma unroll
  for (int r = 0; r < 16; ++r) p0[r] = __builtin_amdgcn_exp2f(p0[r]);
}
__device__ __forceinline__ void finishSM(f32x16& p0, f32x16& p1, float alpha, float& l_reg, bf16x8& pa0, bf16x8& pa1, bf16x8& pa2, bf16x8& pa3) {
#pragma unroll
  for (int r = 0; r < 16; ++r) p1[r] = __builtin_amdgcn_exp2f(p1[r]);
  float ps = 0;
#pragma unroll
  for (int r = 0; r < 16; ++r) ps += p0[r];
#pragma unroll
  for (int r = 0; r < 16; ++r) ps += p1[r];
  { auto rr = __builtin_amdgcn_permlane32_swap(__float_as_uint(ps), __float_as_uint(ps), false, false);
    ps = __uint_as_float(rr[0]) + __uint_as_float(rr[1]); }
  l_reg = l_reg * alpha + ps;
#define PK4(P, BASE, OUT) do { unsigned a0 = cvtpk(P[BASE + 0], P[BASE + 1]), a1 = cvtpk(P[BASE + 2], P[BASE + 3]);   \
    unsigned b0 = cvtpk(P[BASE + 4], P[BASE + 5]), b1 = cvtpk(P[BASE + 6], P[BASE + 7]);                              \
    auto r0 = __builtin_amdgcn_permlane32_swap(a0, b0, false, false); auto r1 = __builtin_amdgcn_permlane32_swap(a1, b1, false, false); \
    v4u w = {r0[0], r1[0], r0[1], r1[1]}; OUT = __builtin_bit_cast(bf16x8, w); } while (0)
  PK4(p0, 0, pa0); PK4(p0, 8, pa1); PK4(p1, 0, pa2); PK4(p1, 8, pa3);
#undef PK4
}
template <int ND0>
__device__ __forceinline__ void qkt(f32x16& p0, f32x16& p1, const LAS char* Ks, const bf16x8* qr, int r32, int hi, int dbase) {
  p0 = f32x16{}; p1 = f32x16{};
#pragma unroll
  for (int d0 = 0; d0 < ND0; ++d0) { const int cb = (dbase + d0 * 16 + hi * 8) * 2;
    const bf16x8 b0 = *(const LAS bf16x8*)(Ks + KSWZ(r32, cb));
    const bf16x8 b1 = *(const LAS bf16x8*)(Ks + KSWZ(32 + r32, cb));
    p0 = __builtin_amdgcn_mfma_f32_32x32x16_bf16(b0, qr[d0], p0, 0, 0, 0);
    p1 = __builtin_amdgcn_mfma_f32_32x32x16_bf16(b1, qr[d0], p1, 0, 0, 0); }
}
__device__ __forceinline__ int v_st(int k, int c) { const int kk = (k & ~0xC) | ((k & 4) << 1) | ((k & 8) >> 1); return ((kk >> 3) * 4 + (c >> 5)) * 512 + ((kk & 7) * 32 + (c & 31)) * 2; }
__device__ __forceinline__ int v_rd_base(int lane) { return ((lane & 3) << 3) | (((lane >> 2) & 3) << 6) | (((lane >> 4) & 1) << 5) | (((lane >> 5) & 1) << 8); }
constexpr int v_rd_off(int d0, int ks, int half) { return d0 * 512 + ks * 4096 + half * 2048; }
template <int OFF> __device__ __forceinline__ s16x4 tr_read(int vb) {
  s16x4 r; asm volatile("ds_read_b64_tr_b16 %0, %1 offset:%2" : "=&v"(r) : "v"(vb), "i"(OFF) : "memory"); return r;
}
template <int D0> __device__ __forceinline__ void pv_one(f32x16& od, int vb, bf16x8 pa0, bf16x8 pa1, bf16x8 pa2, bf16x8 pa3) {
  const s16x4 l0 = tr_read<v_rd_off(D0, 0, 0)>(vb), h0 = tr_read<v_rd_off(D0, 0, 1)>(vb), l1 = tr_read<v_rd_off(D0, 1, 0)>(vb), h1 = tr_read<v_rd_off(D0, 1, 1)>(vb);
  const s16x4 l2 = tr_read<v_rd_off(D0, 2, 0)>(vb), h2 = tr_read<v_rd_off(D0, 2, 1)>(vb), l3 = tr_read<v_rd_off(D0, 3, 0)>(vb), h3 = tr_read<v_rd_off(D0, 3, 1)>(vb);
  asm volatile("s_waitcnt lgkmcnt(0)" ::: "memory"); SBAR();
#define PK(L, H) (bf16x8){L[0], L[1], L[2], L[3], H[0], H[1], H[2], H[3]}
  od = __builtin_amdgcn_mfma_f32_32x32x16_bf16(pa0, PK(l0, h0), od, 0, 0, 0);
  od = __builtin_amdgcn_mfma_f32_32x32x16_bf16(pa1, PK(l1, h1), od, 0, 0, 0);
  od = __builtin_amdgcn_mfma_f32_32x32x16_bf16(pa2, PK(l2, h2), od, 0, 0, 0);
  od = __builtin_amdgcn_mfma_f32_32x32x16_bf16(pa3, PK(l3, h3), od, 0, 0, 0);
#undef PK
}
__device__ __forceinline__ void pv_d0(f32x16* o, int vb, bf16x8 pa0, bf16x8 pa1, bf16x8 pa2, bf16x8 pa3) {
  pv_one<0>(o[0], vb, pa0, pa1, pa2, pa3); pv_one<1>(o[1], vb, pa0, pa1, pa2, pa3); pv_one<2>(o[2], vb, pa0, pa1, pa2, pa3); pv_one<3>(o[3], vb, pa0, pa1, pa2, pa3);
}

struct AUnit {
  const bf16* Q;
  const bf16* K1; const bf16* V1; int s1, n1;
  const bf16* K2; const bf16* V2; int s2, n2;
  bf16* O;
  int rlo, qa;
  const float* rpb;
};

template <int KIND, int PASS>
__device__ __forceinline__ void attn_unit(const AUnit& U, LAS char* lds, int tid_in, float lam, float onemli, const float* dg, float* stash) {
  int tid = tid_in; asm volatile("" : "+v"(tid));
  constexpr int ND0 = (KIND == 2) ? 4 : 8;
  constexpr float SCALE = Sc<KIND>::SCALE;
  const int wid = __builtin_amdgcn_readfirstlane(tid >> 6), lane = tid & 63, r32 = lane & 31, hi = lane >> 5;
  LAS char* V_lds = lds; LAS char* K_lds = lds + 2 * SHM_V;
  LAS float* wsl = (LAS float*)(lds + OFF_WS) + wid * 64; LAS float* li_l = wsl; LAS float* al_l = wsl + 32;
  LAS float* btab = (LAS float*)(lds + OFF_BT);
  const int NT = U.n1 + U.n2;
  const int sr = tid >> 4, sc = (tid & 15) * 8, vst0 = v_st(sr, sc), vst1 = v_st(32 + sr, sc);
  const int vb0 = (int)(unsigned)(uintptr_t)V_lds + v_rd_base(lane);
  int na_rq = 0, na_r0 = 0, na_t = 0, na_b = 0;
  if (KIND == 1) {
    for (int i = tid; i < 576; i += 512) btab[i] = (i >= 48 && i < 48 + 465) ? U.rpb[i - 48] * (1.0f / SCALE) : 0.f;
    const int cq = 32 * (wid & 1) + r32; na_rq = 4 * U.qa + (wid >> 1); na_r0 = min(max(na_rq - 4, 0), 8);
    na_t = 4 * hi - min(max(cq - 8, 0), 48); na_b = 48 + 4 * hi - cq + 15;
  }
  {
  constexpr int pass = PASS; constexpr int dbase = (KIND == 2) ? PASS * 64 : 0;
  float m_reg = -1e30f, l_reg = 0; f32x16 o[4] = {}; bf16x8 qr[ND0];
  { const bf16* Qw = U.Q + (size_t)(wid * QBLK + r32) * DIN + hi * 8 + dbase;
#pragma unroll
    for (int d0 = 0; d0 < ND0; ++d0) qr[d0] = *(const bf16x8*)(Qw + d0 * 16); }
  struct { bf16x8 vs0, vs1, ks0, ks1; } sr_[2];
#define TILE_PTRS(j) const bool s2_ = (j) >= U.n1; const int tt_ = s2_ ? (j) - U.n1 : (j); const int st_ = s2_ ? U.s2 : U.s1; \
    const bf16* Kt_ = (s2_ ? U.K2 : U.K1) + (size_t)tt_ * 64 * st_; const bf16* Vt_ = (s2_ ? U.V2 : U.V1) + (size_t)tt_ * 64 * st_;
#define SLOAD(i, j) do { TILE_PTRS(j) sr_[i].vs0 = *(const bf16x8*)(Vt_ + (size_t)sr * st_ + sc); sr_[i].vs1 = *(const bf16x8*)(Vt_ + (size_t)(32 + sr) * st_ + sc); \
    sr_[i].ks0 = *(const bf16x8*)(Kt_ + (size_t)sr * st_ + sc); sr_[i].ks1 = *(const bf16x8*)(Kt_ + (size_t)(32 + sr) * st_ + sc); } while (0)
#define SWRITE(b, i) do { *(LAS bf16x8*)(V_lds + (b) * SHM_V + vst0) = sr_[i].vs0; *(LAS bf16x8*)(V_lds + (b) * SHM_V + vst1) = sr_[i].vs1; const int kc = sc * 2; \
    *(LAS bf16x8*)(K_lds + (b) * SHM_K + KSWZ(sr, kc)) = sr_[i].ks0; *(LAS bf16x8*)(K_lds + (b) * SHM_K + KSWZ(32 + sr, kc)) = sr_[i].ks1; } while (0)
#define SWAIT() asm volatile("s_waitcnt vmcnt(4)" ::: "memory")
#define RESC(a) do { if (__any((a) < 1.f)) { if (hi == 0) al_l[r32] = (a); asm volatile("s_waitcnt lgkmcnt(0)" ::: "memory"); \
    _Pragma("unroll") for (int d = 0; d < 4; ++d) _Pragma("unroll") for (int r = 0; r < 16; ++r) o[d][r] *= al_l[crow(r, hi)]; } } while (0)
#define NABIAS(P0, P1, j) do { if (KIND == 1 && (j) >= U.n1) { const int rk = U.rlo + (j) - U.n1; const bool inw = (unsigned)(rk - na_r0) < 8u; \
    const int dr = min(max(rk - na_rq + 7, 0), 14); const LAS float* bp = btab + dr * 31 + na_b; const int tt = inw ? na_t : 1000; \
    _Pragma("unroll") for (int r = 0; r < 16; ++r) { const int co = (r & 3) + 8 * (r >> 2); \
      P0[r] = ((unsigned)(co + tt) < 16u) ? P0[r] + bp[co] : -1e30f; P1[r] = ((unsigned)(co + 32 + tt) < 16u) ? P1[r] + bp[co + 32] : -1e30f; } } } while (0)
  f32x16 pA0, pA1, pB0, pB1; float mnA, mnB, alA, alB; bf16x8 pa0, pa1, pa2, pa3;
  constexpr int SE = 0, SO = 1;
  __syncthreads();
  SLOAD(SE, 0); asm volatile("s_waitcnt vmcnt(0)" ::: "memory"); SWRITE(0, SE); __syncthreads();
  qkt<ND0>(pA0, pA1, K_lds, qr, r32, hi, dbase); NABIAS(pA0, pA1, 0); partialSM<KIND>(pA0, pA1, m_reg, mnA, alA);
  SLOAD(SO, 1); SLOAD(SE, 2);
  SWAIT(); SWRITE(1, SO); __syncthreads();
  for (int j = 1; j + 1 < NT; j += 2) {
    SBAR(); qkt<ND0>(pB0, pB1, K_lds + SHM_K, qr, r32, hi, dbase);
    finishSM(pA0, pA1, alA, l_reg, pa0, pa1, pa2, pa3); SBAR();
    SLOAD(SO, (j + 2 < NT) ? j + 2 : j); SBAR();
    pv_d0(o, vb0, pa0, pa1, pa2, pa3); NABIAS(pB0, pB1, j); partialSM<KIND>(pB0, pB1, m_reg, mnB, alB);
    __syncthreads(); SWAIT(); SWRITE(0, SE);
    RESC(alB); __syncthreads();
    SBAR(); qkt<ND0>(pA0, pA1, K_lds, qr, r32, hi, dbase);
    finishSM(pB0, pB1, alB, l_reg, pa0, pa1, pa2, pa3); SBAR();
    SLOAD(SE, (j + 3 < NT) ? j + 3 : NT - 1); SBAR();
    pv_d0(o, vb0 + SHM_V, pa0, pa1, pa2, pa3); NABIAS(pA0, pA1, j + 1); partialSM<KIND>(pA0, pA1, m_reg, mnA, alA);
    __syncthreads(); SWAIT(); SWRITE(1, SO);
    RESC(alA); __syncthreads();
  }
  SBAR(); qkt<ND0>(pB0, pB1, K_lds + SHM_K, qr, r32, hi, dbase);
  finishSM(pA0, pA1, alA, l_reg, pa0, pa1, pa2, pa3); SBAR();
  pv_d0(o, vb0, pa0, pa1, pa2, pa3); NABIAS(pB0, pB1, NT - 1); partialSM<KIND>(pB0, pB1, m_reg, mnB, alB);
  __syncthreads(); RESC(alB);
  finishSM(pB0, pB1, alB, l_reg, pa0, pa1, pa2, pa3); SBAR();
  pv_d0(o, vb0 + SHM_V, pa0, pa1, pa2, pa3);
  asm volatile("s_waitcnt vmcnt(0)" ::: "memory");
  if (hi == 0) li_l[r32] = l_reg; asm volatile("s_waitcnt lgkmcnt(0)" ::: "memory");
  float rli[16];
#pragma unroll
  for (int r = 0; r < 16; ++r) rli[r] = __builtin_amdgcn_rcpf(li_l[crow(r, hi)]);
  if (KIND != 2) {
    bf16* Ow = U.O + (size_t)(wid * QBLK) * DM;
#pragma unroll
    for (int r = 0; r < 16; ++r) { const int orow = crow(r, hi);
#pragma unroll
      for (int d0 = 0; d0 < 4; ++d0) Ow[(size_t)orow * DM + d0 * 32 + r32] = (bf16)f2bf(o[d0][r] * rli[r]); }
  } else if (pass == 0) {
#pragma unroll
    for (int d0 = 0; d0 < 4; ++d0) { float* sw = stash + wid * 4096 + d0 * 1024 + lane;
#pragma unroll
      for (int r = 0; r < 16; ++r) sw[r * 64] = o[d0][r] * rli[r]; }
  } else {
    float gcol[4];
#pragma unroll
    for (int d0 = 0; d0 < 4; ++d0) gcol[d0] = dg[d0 * 32 + r32] * onemli;
    bf16* Ow = U.O + (size_t)(wid * QBLK) * DM;
#pragma unroll
    for (int r = 0; r < 16; ++r) {
      float v[4]; float ss = 0.f;
#pragma unroll
      for (int d0 = 0; d0 < 4; ++d0) { v[d0] = stash[wid * 4096 + d0 * 1024 + lane + r * 64] - lam * (o[d0][r] * rli[r]); ss += v[d0] * v[d0]; }
#pragma unroll
      for (int off = 1; off < 32; off <<= 1) ss += __shfl_xor(ss, off);
      const float rs = 1.0f / sqrtf(ss * (1.0f / 128.0f) + EPS);
      const int orow = crow(r, hi);
#pragma unroll
      for (int d0 = 0; d0 < 4; ++d0) Ow[(size_t)orow * DM + d0 * 32 + r32] = (bf16)f2bf(v[d0] * rs * gcol[d0]);
      asm volatile("" ::: "memory");
    }
  }
  }
#undef TILE_PTRS
#undef SLOAD
#undef SWRITE
#undef SWAIT
#undef RESC
#undef NABIAS
}
#undef KSWZ
#undef SBAR
}

constexpr int CW_ATTQ = 3584;
constexpr size_t WS_STASH = 896 * MiB;
constexpr size_t WS_END2 = 976 * MiB;

__device__ __forceinline__ int attq_next(unsigned* ctr, LAS char* lds, int tid) {
  LAS int* slot = (LAS int*)(lds + att::OFF_Q);
  __syncthreads();
  if (tid == 0) *slot = (int)__hip_atomic_fetch_add(ctr, 1u, __ATOMIC_RELAXED, __HIP_MEMORY_SCOPE_AGENT);
  __syncthreads();
  return *slot;
}

#ifndef PROBE_SITE
#define PROBE_SITE -1
#endif
__device__ __forceinline__ void ph_attn(CArgs* a, const Ctx& X, int l, int rep, unsigned long long& pacc) {
  unsigned char* ws = a->ws;
  const bf16* QKV = (const bf16*)(ws + WS_QKV); bf16* AO = (bf16*)(ws + WS_AO);
  unsigned* ctl = (unsigned*)(ws + WS_CTL);
  LAS char* lds = (LAS char*)X.lds;
#ifndef AMASK
#define AMASK 7
#endif
  if (AMASK & 1)
  for (;;) {
    unsigned long long tq_ = 0; if (PROBE_SITE == 13) tq_ = __builtin_amdgcn_s_memrealtime();
    const int i = attq_next(ctl + CW_ATTQ + 64 * (3 * l + 0 + 12 * rep), lds, X.tid);
    if (PROBE_SITE == 13) pacc += __builtin_amdgcn_s_memrealtime() - tq_;
    if (i >= 192) break;
    if (PROBE_SITE == 14) tq_ = __builtin_amdgcn_s_memrealtime();
    att::AUnit U{};
    if (i < 128) { const int b = i >> 4, h = (i >> 2) & 3, qb = i & 3; const size_t r0 = (size_t)NCTX + b * LAT_T;
      U.Q = QKV + (r0 + qb * 256) * DIN + C_DQ + h * 128; U.O = AO + (r0 + qb * 256) * DM + AO_D + h * 128;
      const size_t co = ((size_t)(b * DEPTH + l) * PAST) * 512 + h * 128;
      U.K1 = (const bf16*)(ws + WS_CDK) + co; U.V1 = (const bf16*)(ws + WS_CDV) + co; U.s1 = 512; U.n1 = 4;
      U.K2 = QKV + r0 * DIN + C_DK + h * 128; U.V2 = QKV + r0 * DIN + C_DV + h * 128; U.s2 = DIN; U.n2 = 16;
    } else { const int j = i - 128, b = j >> 2, h = j & 3; const size_t r0 = (size_t)b * CTX_T;
      U.Q = QKV + r0 * DIN + C_DQ + h * 128; U.O = AO + r0 * DM + AO_D + h * 128;
      U.K1 = QKV + r0 * DIN + C_DK + h * 128; U.V1 = QKV + r0 * DIN + C_DV + h * 128; U.s1 = DIN; U.n1 = 4; U.K2 = U.K1; U.V2 = U.V1; U.s2 = DIN; U.n2 = 0; }
    #ifndef DPASS
#define DPASS 3
#endif
    float* stash = (float*)(ws + WS_STASH) + (size_t)blockIdx.x * 32768;
    const float li = lambda_init_of(l);
    const float* lamv = a->in[I_LAM] + l * 256;
    const float lam = expf(wave_sum(lamv[X.lane] * lamv[64 + X.lane])) - expf(wave_sum(lamv[128 + X.lane] * lamv[192 + X.lane])) + li;
    const float* dg = a->in[I_DG] + l * 128;
    if (DPASS & 1) att::attn_unit<2, 0>(U, lds, X.tid, lam, 1.0f - li, dg, stash);
    if (DPASS & 2) att::attn_unit<2, 1>(U, lds, X.tid, lam, 1.0f - li, dg, stash);
    if (PROBE_SITE == 14) pacc += __builtin_amdgcn_s_memrealtime() - tq_;
  }
  if (AMASK & 2)
  for (;;) {
    unsigned long long tq_ = 0; if (PROBE_SITE == 13) tq_ = __builtin_amdgcn_s_memrealtime();
    const int i = attq_next(ctl + CW_ATTQ + 64 * (3 * l + 1 + 12 * rep), lds, X.tid);
    if (PROBE_SITE == 13) pacc += __builtin_amdgcn_s_memrealtime() - tq_;
    if (i >= 128) break;
    if (PROBE_SITE == 15) tq_ = __builtin_amdgcn_s_memrealtime();
    att::AUnit U{};
    const int b = i >> 4, h = (i >> 2) & 3, qb = i & 3; const size_t r0 = (size_t)NCTX + b * LAT_T;
    U.Q = QKV + (r0 + qb * 256) * DIN + C_NAQ + h * 128; U.O = AO + (r0 + qb * 256) * DM + AO_NA + h * 128;
    const size_t co = ((size_t)(b * DEPTH + l) * PAST) * 512 + h * 128;
    U.K1 = (const bf16*)(ws + WS_CNAK) + co; U.V1 = (const bf16*)(ws + WS_CNAV) + co; U.s1 = 512; U.n1 = 4;
    U.rlo = (qb == 0) ? 0 : (qb == 1) ? 0 : (qb == 2) ? 4 : 8; U.n2 = (qb == 0 || qb == 3) ? 8 : 12; U.qa = qb;
    U.K2 = QKV + (r0 + U.rlo * 64) * DIN + C_NAK + h * 128; U.V2 = QKV + (r0 + U.rlo * 64) * DIN + C_NAV + h * 128; U.s2 = DIN;
    U.rpb = a->in[I_RPB] + (size_t)(l * 4 + h) * 465;
    att::attn_unit<1, 0>(U, lds, X.tid, 0.f, 0.f, nullptr, nullptr);
    if (PROBE_SITE == 15) pacc += __builtin_amdgcn_s_memrealtime() - tq_;
  }
  if (AMASK & 4)
  for (;;) {
    unsigned long long tq_ = 0; if (PROBE_SITE == 13) tq_ = __builtin_amdgcn_s_memrealtime();
    const int i = attq_next(ctl + CW_ATTQ + 64 * (3 * l + 2 + 12 * rep), lds, X.tid);
    if (PROBE_SITE == 13) pacc += __builtin_amdgcn_s_memrealtime() - tq_;
    if (i >= 448) break;
    if (PROBE_SITE == 16) tq_ = __builtin_amdgcn_s_memrealtime();
    att::AUnit U{};
    if (i < 256) { const int b = i >> 5, hq = (i >> 2) & 7, qb = i & 3, kvh = hq >> 2; const size_t r0 = (size_t)NCTX + b * LAT_T;
      U.Q = QKV + (r0 + qb * 256) * DIN + C_GQ + hq * 128; U.O = AO + (r0 + qb * 256) * DM + AO_G + hq * 128;
      const size_t co = ((size_t)(b * DEPTH + l) * PAST) * 256 + kvh * 128;
      U.K1 = (const bf16*)(ws + WS_CGK) + co; U.V1 = (const bf16*)(ws + WS_CGV) + co; U.s1 = 256; U.n1 = 4;
      U.K2 = QKV + r0 * DIN + C_GK + kvh * 128; U.V2 = QKV + r0 * DIN + C_GV + kvh * 128; U.s2 = DIN; U.n2 = 16;
    } else if (i < 384) { const int j = i - 256, b = j >> 3, hq = j & 7, kvh = hq >> 2; const size_t r0 = (size_t)b * CTX_T;
      U.Q = QKV + r0 * DIN + C_GQ + hq * 128; U.O = AO + r0 * DM + AO_G + hq * 128;
      U.K1 = QKV + r0 * DIN + C_GK + kvh * 128; U.V1 = QKV + r0 * DIN + C_GV + kvh * 128; U.s1 = DIN; U.n1 = 4; U.K2 = U.K1; U.V2 = U.V1; U.s2 = DIN; U.n2 = 0;
    } else { const int j = i - 384, b = j >> 2, h = j & 3; const size_t r0 = (size_t)b * CTX_T;
      U.Q = QKV + r0 * DIN + C_NAQ + h * 128; U.O = AO + r0 * DM + AO_NA + h * 128;
      U.K1 = QKV + r0 * DIN + C_NAK + h * 128; U.V1 = QKV + r0 * DIN + C_NAV + h * 128; U.s1 = DIN; U.n1 = 4; U.K2 = U.K1; U.V2 = U.V1; U.s2 = DIN; U.n2 = 0; }
    att::attn_unit<0, 0>(U, lds, X.tid, 0.f, 0.f, nullptr, nullptr);
    if (PROBE_SITE == 16) pacc += __builtin_amdgcn_s_memrealtime() - tq_;
  }
}

constexpr int NPHASE = 2 + 8 * DEPTH;
#ifndef IN_FUSED
#define IN_FUSED 2
#endif
#ifndef INMASK
#define INMASK 7
#endif
#ifndef ATTN_NAIVE
#define ATTN_NAIVE 0
#endif
#ifndef MK_SINGLE
#define MK_SINGLE 1
#endif
__global__ void __launch_bounds__(NTHREADS, 2) fwd(Args args_unused) {
    extern __shared__ __attribute__((aligned(16))) unsigned char lds_raw[];
#define CTX_HERE() Ctx X; { int t_ = threadIdx.x; asm volatile("" : "+v"(t_)); X.lds = (LAS unsigned char*)lds_raw; X.tid = t_; X.lane = t_ & 63; X.wave = __builtin_amdgcn_readfirstlane(t_ >> 6); \
    X.G = gridDim.x; const int bx_ = blockIdx.x; X.vcu = (X.G % 8 == 0) ? (bx_ % 8) * (X.G / 8) + bx_ / 8 : bx_; X.gw = X.vcu * NWAVES + X.wave; X.NGW = X.G * NWAVES; }
    LAS unsigned char* const lds0 = (LAS unsigned char*)lds_raw;
    for (int u = threadIdx.x; u < (LDS_BYTES - LDSCTL_OFF) / 4; u += NTHREADS) ((LAS unsigned*)(lds0 + LDSCTL_OFF))[u] = 0u;
    __syncthreads();
    int lo, hi; XcdBarrier bar;
    { CArgs* A = args_here(); lo = A->ph_lo; hi = A->ph_hi; unsigned* ctl = (unsigned*)(A->ws + WS_CTL);
      bar.bar = ctl + CW_BAR; bar.x = 0; bar.st = nullptr;
      if (hi - lo > 1) bar = xcd_barrier_post(ctl + CW_BAR, (volatile LAS unsigned*)(lds0 + MISC_OFF) + 8); }
#ifndef PHMASK
#define PHMASK 0xffff
#endif
#ifndef PROBE_SITE
#define PROBE_SITE -1
#endif
#ifndef PROBE_MULT
#define PROBE_MULT 1
#endif
    unsigned long long pt0_ = 0, pacc_ = 0;
#define PT0(n) do { if (PROBE_SITE == (n)) pt0_ = __builtin_amdgcn_s_memrealtime(); } while (0)
#define PT1(n) do { if (PROBE_SITE == (n)) pacc_ += (__builtin_amdgcn_s_memrealtime() - pt0_) * PROBE_MULT; } while (0)
#define IN(k) (lo <= (k) && (k) < hi)
#define ON(n) ((PHMASK >> (n)) & 1)
#ifndef REPMASK
#define REPMASK 0
#endif
#define REPS(n) (((REPMASK >> (n)) & 1) ? 2 : 1)
#ifndef BARREP
#define BARREP 1
#endif
#define SEAM(k) do { if (IN(k) && IN((k) + 1)) { for (int br_ = 0; br_ < BARREP; ++br_) xcd_barrier(bar); } } while (0)

    if (ON(0) && IN(0)) { PT0(0); CTX_HERE(); CArgs* A = args_here(); for (int rep = 0; rep < REPS(0); ++rep) { ph_prologue(A, X, pacc_); __syncthreads(); } SEAM(0); PT1(0); }
    if (ON(1) && IN(1)) { PT0(1); CTX_HERE(); CArgs* A = args_here(); norm_rows<true, false>(A, X, nullptr, nullptr, nullptr, 0, A->in[I_NORMG], (const float*)(A->ws + WS_MOD), 0, 2048); SEAM(1); PT1(1); }

    for (int l = 0; l < DEPTH; ++l) {
        const int pb = 2 + 8 * l;
        if (ON(2) && IN(pb + 0)) { PT0(2);
            CArgs* A = args_here(); unsigned char* ws = A->ws;
            pg8::Gemm g{(const bf16*)(ws + WS_H), (const bf16*)(ws + WS_WIN) + (size_t)l * DIN * DM, MTOK, DIN, DM};
#if IN_FUSED == 2
            { pg8::InOrder S; S.init(MTOK, DIN, (int)gridDim.x, (int)blockIdx.x);
              pg8::EpiInAll E{pg8::EpiInP{(bf16*)(ws + WS_QKV), A->out, l},
                              pg8::EpiInG{(bf16*)(ws + WS_QKV), A->out, l, A->in[I_QG] + l * 128, A->in[I_KG] + l * 128, (const float*)(ws + WS_ROPE), (LAS float*)(lds0 + RING_BYTES + 1024)},
                              pg8::EpiInD{(bf16*)(ws + WS_QKV), A->out, l, (const float*)(ws + WS_ROPE)}};
              pg8::gemm_phase<pg8::EpiInAll, pg8::InOrder, true, true>(lds0 + RING_OFF, g, S, E); }
            SEAM(pb + 0); PT1(2);
#elif IN_FUSED
            if (INMASK & 1) { PT0(10); pg8::SubOrder<0> S; S.init(MTOK, 9 * 256, (int)gridDim.x, (int)blockIdx.x); pg8::EpiInP E{(bf16*)(ws + WS_QKV), A->out, l};
              pg8::gemm_phase<pg8::EpiInP, pg8::SubOrder<0>, true, true>(lds0 + RING_OFF, g, S, E); PT1(10); }
            if (INMASK & 2) { PT0(11); pg8::SubOrder<1> S; S.init(MTOK, 5 * 256, (int)gridDim.x, (int)blockIdx.x);
              pg8::EpiInG E{(bf16*)(ws + WS_QKV), A->out, l, A->in[I_QG] + l * 128, A->in[I_KG] + l * 128, (const float*)(ws + WS_ROPE), (LAS float*)(lds0 + RING_BYTES + 1024)};
              pg8::gemm_phase<pg8::EpiInG, pg8::SubOrder<1>, true, true>(lds0 + RING_OFF, g, S, E); PT1(11); }
            if (INMASK & 4) { PT0(12); pg8::SubOrder<2> S; S.init(MTOK, 4 * 256, (int)gridDim.x, (int)blockIdx.x); pg8::EpiInD E{(bf16*)(ws + WS_QKV), A->out, l, (const float*)(ws + WS_ROPE)};
              pg8::gemm_phase<pg8::EpiInD, pg8::SubOrder<2>, true, true>(lds0 + RING_OFF, g, S, E); PT1(12); }
            SEAM(pb + 0); PT1(2);
#else
            { pg8::StaticOrder S; S.init(MTOK, DIN, (int)gridDim.x, (int)blockIdx.x); pg8::EpiBf16<0> E{(bf16*)(ws + WS_QKV), DIN};
              pg8::gemm_phase<pg8::EpiBf16<0>, pg8::StaticOrder, true, true>(lds0 + RING_OFF, g, S, E); }
            xcd_barrier(bar); PT1(2);
            { PT0(3); CTX_HERE(); ph_fixup(A, X, l); SEAM(pb + 0); PT1(3); }
#endif
        }
        if (ON(4) && IN(pb + 2)) { PT0(4); CTX_HERE(); CArgs* A = args_here();
#if ATTN_NAIVE
            ph_attn_naive(A, X, l);
#else
            for (int rep = 0; rep < REPS(4); ++rep) ph_attn(A, X, l, rep, pacc_);
#endif
            SEAM(pb + 2); PT1(4); }
        if (ON(5) && IN(pb + 3)) { PT0(5);
            CArgs* A = args_here(); unsigned char* ws = A->ws;
            pg8::Gemm g{(const bf16*)(ws + WS_AO), (const bf16*)(ws + WS_WOUT) + (size_t)l * DM * DM, MTOK, DM, DM}; pg8::SplitTailOrder S; S.init(g.K, (int)gridDim.x, (int)blockIdx.x);
            pg8::EpiBf16Split E{(bf16*)(ws + WS_O2), (bf16*)(ws + WS_O2B)};
            for (int rep = 0; rep < REPS(5); ++rep) pg8::gemm_phase<pg8::EpiBf16Split, pg8::SplitTailOrder, true, true>(lds0 + RING_OFF, g, S, E);
            SEAM(pb + 3); PT1(5);
        }
        if (ON(6) && IN(pb + 4)) { PT0(6); CTX_HERE(); CArgs* A = args_here(); const float* normg = A->in[I_NORMG]; const float* modl = (const float*)(A->ws + WS_MOD) + (size_t)l * 9 * NMODW;
            norm_rows<false, false>(A, X, (const bf16*)(A->ws + WS_O2), normg + (size_t)(l * 4 + 1) * DM, modl, 4096, normg + (size_t)(l * 4 + 2) * DM, modl, 6144, 8192); SEAM(pb + 4); PT1(6); }
        if (ON(7) && IN(pb + 5)) { PT0(7);
            CArgs* A = args_here(); unsigned char* ws = A->ws;
            pg8::Gemm g{(const bf16*)(ws + WS_H), (const bf16*)(ws + WS_WUP) + (size_t)l * DFF * DM, MTOK, DFF, DM}; pg8::StaticOrder S; S.init(MTOK, DFF, (int)gridDim.x, (int)blockIdx.x);
            pg8::EpiBf16<2> E{(bf16*)(ws + WS_U), DFF};
            for (int rep = 0; rep < REPS(7); ++rep) pg8::gemm_phase<pg8::EpiBf16<2>, pg8::StaticOrder, true, true>(lds0 + RING_OFF, g, S, E);
            SEAM(pb + 5); PT1(7);
        }
        if (ON(8) && IN(pb + 6)) { PT0(8);
            CArgs* A = args_here(); unsigned char* ws = A->ws;
            pg8::Gemm g{(const bf16*)(ws + WS_U), (const bf16*)(ws + WS_WDN) + (size_t)l * DM * DFF, MTOK, DM, DFF}; pg8::SplitTailOrder S; S.init(g.K, (int)gridDim.x, (int)blockIdx.x);
            pg8::EpiBf16Split E{(bf16*)(ws + WS_O2), (bf16*)(ws + WS_O2B)};
            for (int rep = 0; rep < REPS(8); ++rep) pg8::gemm_phase<pg8::EpiBf16Split, pg8::SplitTailOrder, true, true>(lds0 + RING_OFF, g, S, E);
            SEAM(pb + 6); PT1(8);
        }
        if (ON(9) && IN(pb + 7)) { PT0(9);
            CTX_HERE(); CArgs* A = args_here(); const float* normg = A->in[I_NORMG]; const float* mod_all = (const float*)(A->ws + WS_MOD);
            const int ln = (l + 1 < DEPTH) ? l + 1 : l;
            if (l + 1 < DEPTH) norm_rows<false, false>(A, X, (const bf16*)(A->ws + WS_O2), normg + (size_t)(l * 4 + 3) * DM, mod_all + (size_t)l * 9 * NMODW, 10240, normg + (size_t)(ln * 4 + 0) * DM, mod_all + (size_t)ln * 9 * NMODW, 0, 2048);
            else norm_rows<false, true>(A, X, (const bf16*)(A->ws + WS_O2), normg + (size_t)(l * 4 + 3) * DM, mod_all + (size_t)l * 9 * NMODW, 10240, nullptr, nullptr, 0, 0);
            SEAM(pb + 7); PT1(9);
        }
    }
    if (PROBE_SITE >= 0) { const unsigned long long tgt_ = __builtin_amdgcn_s_memrealtime() + pacc_; while (__builtin_amdgcn_s_memrealtime() < tgt_) __builtin_amdgcn_s_sleep(32); }
#undef IN
#undef SEAM
}

extern "C" void kernel_launch(void* const* d_in, const int* in_sizes, int n_in, void* d_out, int out_size, void* d_ws, size_t ws_size, hipStream_t stream) {
    static int grid = 0;
    if (grid == 0) {
        if (n_in != 22 || out_size != (int)OUT_END || ws_size < WS_END2) { fprintf(stderr, "kernel_launch: unexpected shapes: n_in %d out %d ws %zu\n", n_in, out_size, ws_size); grid = -1; return; }
        int dev = 0, cus = 0, per_cu = 0;
        if (hipGetDevice(&dev) != hipSuccess || hipDeviceGetAttribute(&cus, hipDeviceAttributeMultiprocessorCount, dev) != hipSuccess) { grid = -1; return; }
        if (hipFuncSetAttribute((const void*)fwd, hipFuncAttributeMaxDynamicSharedMemorySize, LDS_BYTES) != hipSuccess) { fprintf(stderr, "kernel_launch: hipFuncSetAttribute failed\n"); grid = -1; return; }
        if (hipOccupancyMaxActiveBlocksPerMultiprocessor(&per_cu, (const void*)fwd, NTHREADS, LDS_BYTES) != hipSuccess || per_cu < 1) fprintf(stderr, "kernel_launch: occupancy query says %d\n", per_cu);
        (void)hipGetLastError();
        grid = cus;
    }
    if (grid < 0) return;
    (void)hipMemsetAsync((char*)d_ws + WS_CTL, 0, CTL_ZERO_BYTES, stream);
    Args a{};
    for (int i = 0; i < 22; ++i) a.in[i] = (const float*)d_in[i];
    a.out = (float*)d_out; a.ws = (unsigned char*)d_ws;
#if MK_SINGLE
    a.ph_lo = 0; a.ph_hi = NPHASE;
    hipLaunchKernelGGL(fwd, dim3(grid), dim3(NTHREADS), LDS_BYTES, stream, a);
#else
    for (int p = 0; p < NPHASE; ++p) { a.ph_lo = p; a.ph_hi = p + 1; hipLaunchKernelGGL(fwd, dim3(grid), dim3(NTHREADS), LDS_BYTES, stream, a); }
#endif
    const hipError_t le = hipPeekAtLastError();
    if (le != hipSuccess) fprintf(stderr, "kernel_launch: launch failed: %s\n", hipGetErrorName(le));
}
```
